# Optimizing an MI355X kernel written in HIP

```python
import numpy as np
import jax
import jax.numpy as jnp
from jax import lax

D_MODEL = 1024
BATCH = 2
SEQ = 16384
DEPTH = 4

CTX_LEN = 256
GRID_W = 64
D_A = 1024
H_A = 4
DH_A = D_A // H_A
D_B = 1024
H_B = 8
DH_B = D_B // H_B
CHUNK_A = 64
CHUNK_B = 16
CONV_K = 3
EPS = 1e-6
NEG = -1e30
MLSTM_F_BIAS = 3.0
IN_SIZES = (2 * D_A, D_A, D_A, D_A, 4 * H_A, D_B, D_B, D_B, D_B, D_B, D_MODEL, D_MODEL)
N_IN = sum(IN_SIZES)

kernel_name = "hybrid_mlstm_hgrn2_diffusion_prefix"


def rmsnorm(x, g):
    xf = x.astype(jnp.float32)
    y = xf * lax.rsqrt(jnp.mean(xf * xf, axis=-1, keepdims=True) + EPS)
    return (y * g.astype(jnp.float32)).astype(x.dtype)


def head_rmsnorm(h, g):
    y = h * lax.rsqrt(jnp.mean(h * h, axis=-1, keepdims=True) + EPS)
    return y.reshape(h.shape[0], h.shape[1], -1) * g.astype(jnp.float32)


def split_in(p):
    idx = []
    acc = 0
    for s in IN_SIZES[:-1]:
        acc += s
        idx.append(acc)
    return jnp.split(p, idx, axis=-1)


def to_chunks(a, L):
    Bn, T, H = a.shape[:3]
    a = a.reshape((Bn, T // L, L, H) + a.shape[3:])
    return jnp.transpose(a, (1, 0, 3, 2) + tuple(range(4, a.ndim)))


def from_chunks(h):
    NC, Bn, H, L, d = h.shape
    return jnp.transpose(h, (1, 0, 3, 2, 4)).reshape(Bn, NC * L, H, d)


def mlstm_chunk_step(carry, xs):
    C, n, m = carry
    q, k, v, li, lf = xs
    L = q.shape[2]
    causal = jnp.tril(jnp.ones((L, L), dtype=bool))
    b = jnp.cumsum(lf, axis=-1)
    D = jnp.where(causal, b[..., :, None] - b[..., None, :] + li[..., None, :], NEG)
    inter = b + m[..., None]
    m_t = jnp.maximum(inter, jnp.max(D, axis=-1))
    w = jnp.einsum('bhtd,bhsd->bhts', q, k) * jnp.exp(D - m_t[..., None])
    a_inter = jnp.exp(inter - m_t)
    num = a_inter[..., None] * jnp.einsum('bhtd,bhde->bhte', q, C) + jnp.einsum('bhts,bhse->bhte', w, v)
    den = a_inter * jnp.einsum('bhtd,bhd->bht', q, n) + jnp.sum(w, axis=-1)
    h = num / jnp.maximum(jnp.abs(den), jnp.exp(-m_t))[..., None]
    bL = b[..., -1]
    ws = bL[..., None] - b + li
    m_new = jnp.maximum(bL + m, jnp.max(ws, axis=-1))
    decay = jnp.exp(bL + m - m_new)
    ws_e = jnp.exp(ws - m_new[..., None])
    kw = k * ws_e[..., None]
    C_new = decay[..., None, None] * C + jnp.einsum('bhsd,bhse->bhde', kw, v)
    n_new = decay[..., None] * n + jnp.sum(kw, axis=2)
    return (C_new, n_new, m_new), h


def mlstm_scan(q, k, v, li, lf, state):
    xs = tuple(to_chunks(a, CHUNK_A) for a in (q, k, v, li, lf))
    state, h = lax.scan(mlstm_chunk_step, state, xs)
    return from_chunks(h), state


def hgrn_chunk_step(S, xs):
    q, v, k, lf = xs
    L = q.shape[2]
    causal = jnp.tril(jnp.ones((L, L), dtype=bool))[:, :, None]
    g = jnp.cumsum(lf, axis=2)
    o_inter = jnp.einsum('bhtc,bhce->bhte', q * jnp.exp(g), S)
    rel = jnp.where(causal, g[:, :, :, None, :] - g[:, :, None, :, :], 0.0)
    dec = jnp.where(causal, jnp.exp(rel), 0.0)
    a = jnp.einsum('bhtsc,bhsc->bhts', q[:, :, :, None, :] * dec, k)
    o = o_inter + jnp.einsum('bhts,bhse->bhte', a, v)
    gL = g[:, :, -1:, :]
    S_new = jnp.exp(gL[:, :, 0, :])[..., None] * S + jnp.einsum('bhsc,bhse->bhce', k * jnp.exp(gL - g), v)
    return S_new, o


def hgrn_scan(q, v, k, lf, state):
    xs = tuple(to_chunks(a, CHUNK_B) for a in (q, v, k, lf))
    state, o = lax.scan(hgrn_chunk_step, state, xs)
    return from_chunks(o), state


def bidirectional(scan_fn, init, ctx_shared, ctx_fwd, ctx_bwd, lat_shared, lat_fwd, lat_bwd, with_ctx_out):
    flip = lambda ts: tuple(jnp.flip(t, axis=1) for t in ts)
    hc_f, s_f = scan_fn(*ctx_shared, *ctx_fwd, init)
    hc_b, s_b = scan_fn(*flip(ctx_shared), *flip(ctx_bwd), init)
    h_f, _ = scan_fn(*lat_shared, *lat_fwd, s_f)
    h_b, _ = scan_fn(*flip(lat_shared), *flip(lat_bwd), s_b)
    h = h_f + jnp.flip(h_b, axis=1)
    hc = hc_f + jnp.flip(hc_b, axis=1) if with_ctx_out else None
    return h, hc


def conv_grid(u, w, b, rows):
    Bn, T, Cn = u.shape
    y = lax.conv_general_dilated(u.reshape(Bn, rows, GRID_W, Cn), w[:, :, None, :].astype(u.dtype),
                                 (1, 1), 'SAME', dimension_numbers=('NHWC', 'HWIO', 'NHWC'),
                                 feature_group_count=Cn)
    return y.reshape(Bn, T, Cn) + b.astype(u.dtype)


def conv_seq(u, w, b):
    Cn = u.shape[-1]
    y = lax.conv_general_dilated(u, w[1][:, None, :].astype(u.dtype), (1,), 'SAME',
                                 dimension_numbers=('NWC', 'WIO', 'NWC'), feature_group_count=Cn)
    return y + b.astype(u.dtype)


def prep(p, conv_fn, lb):
    f32 = jnp.float32
    qk, v, o, z_a, g_a, q_b, i_b, f_bf, f_bb, z_b, m_a, m_b = split_in(p)
    Bn, T = p.shape[:2]
    qk = jax.nn.silu(conv_fn(qk)).astype(f32)
    q_a = qk[..., :D_A].reshape(Bn, T, H_A, DH_A)
    k_a = qk[..., D_A:].reshape(Bn, T, H_A, DH_A) * (DH_A ** -0.5)
    v_a = v.astype(f32).reshape(Bn, T, H_A, DH_A)
    g_a = g_a.astype(f32).reshape(Bn, T, 4, H_A)
    a_fwd = (g_a[:, :, 0], jax.nn.log_sigmoid(g_a[:, :, 1]))
    a_bwd = (g_a[:, :, 2], jax.nn.log_sigmoid(g_a[:, :, 3]))

    def decay(f_raw):
        fr = f_raw.astype(f32)
        log_f = jax.nn.log_sigmoid(fr) + jnp.log1p(lb * jnp.exp(-fr))
        k = (1.0 - lb) * jax.nn.sigmoid(-fr)
        return (k.reshape(Bn, T, H_B, DH_B), log_f.reshape(Bn, T, H_B, DH_B))

    b_shared = (q_b.astype(f32).reshape(Bn, T, H_B, DH_B), i_b.astype(f32).reshape(Bn, T, H_B, DH_B))
    return ((q_a, k_a, v_a), a_fwd, a_bwd, b_shared, decay(f_bf), decay(f_bb), (o, z_a, z_b, m_a, m_b))


def merge(h_a, h_b, post, g_head_a, g_head_b, w_a, w_b, w_out, dtype):
    o, z_a, z_b, m_a, m_b = post
    Bn, T = h_a.shape[:2]
    f32 = jnp.float32
    o_gate = jax.nn.sigmoid(o.astype(f32)).reshape(Bn, T, H_A, DH_A)
    y_a = head_rmsnorm(h_a * o_gate, g_head_a) * jax.nn.silu(z_a.astype(f32))
    y_b = head_rmsnorm(h_b, g_head_b) * jax.nn.silu(z_b.astype(f32))
    y = (jax.nn.sigmoid(m_a) * (y_a.astype(dtype) @ w_a)
         + jax.nn.sigmoid(m_b) * (y_b.astype(dtype) @ w_b))
    return y @ w_out


def trunk_layer(x, xc, c, c_ctx, w_ada, b_ada, g_norm, w_in, b_in, w_conv, b_conv, lb,
                g_head_a, g_head_b, w_a, w_b, w_out, rows, with_ctx_out):
    shift, scale, gate = jnp.split(jax.nn.silu(c) @ w_ada + b_ada, 3, axis=-1)
    shift_c, scale_c, gate_c = jnp.split(jax.nn.silu(c_ctx) @ w_ada + b_ada, 3, axis=-1)
    h = rmsnorm(x, g_norm) * (1 + scale[:, None]) + shift[:, None]
    hc = rmsnorm(xc, g_norm) * (1 + scale_c) + shift_c
    lat = prep(h @ w_in + b_in, lambda u: conv_grid(u, w_conv, b_conv, rows), lb)
    con = prep(hc @ w_in + b_in, lambda u: conv_seq(u, w_conv, b_conv), lb)
    Bn = x.shape[0]
    f32 = jnp.float32
    init_a = (jnp.zeros((Bn, H_A, DH_A, DH_A), f32), jnp.zeros((Bn, H_A, DH_A), f32), jnp.zeros((Bn, H_A), f32))
    init_b = jnp.zeros((Bn, H_B, DH_B, DH_B), f32)
    h_a, hc_a = bidirectional(mlstm_scan, init_a, con[0], con[1], con[2], lat[0], lat[1], lat[2], with_ctx_out)
    h_b, hc_b = bidirectional(hgrn_scan, init_b, con[3], con[4], con[5], lat[3], lat[4], lat[5], with_ctx_out)
    x = x + gate[:, None] * merge(h_a, h_b, lat[6], g_head_a, g_head_b, w_a, w_b, w_out, x.dtype)
    if with_ctx_out:
        xc = xc + gate_c * merge(hc_a, hc_b, con[6], g_head_a, g_head_b, w_a, w_b, w_out, xc.dtype)
    return x, xc


def setup_inputs(seed: int = 0) -> dict:
    key = jax.random.key(seed)
    ks = jax.random.split(key, 20)
    nrm = jax.random.normal
    f_off = 2 * D_A + 3 * D_A + H_A
    fb_off = 2 * D_A + 3 * D_A + 3 * H_A
    b_in = 0.01 * nrm(ks[8], (DEPTH, N_IN), jnp.float32)
    b_in = b_in.at[:, f_off:f_off + H_A].add(MLSTM_F_BIAS).at[:, fb_off:fb_off + H_A].add(MLSTM_F_BIAS)
    return {
        "x": nrm(ks[0], (BATCH, SEQ, D_MODEL), jnp.float32),
        "c": nrm(ks[1], (BATCH, D_MODEL), jnp.float32),
        "ctx": nrm(ks[2], (BATCH, CTX_LEN, D_MODEL), jnp.float32),
        "c_ctx": nrm(ks[3], (D_MODEL,), jnp.float32),
        "w_ada": nrm(ks[4], (DEPTH, D_MODEL, 3 * D_MODEL), jnp.float32) * (0.5 * D_MODEL ** -0.5),
        "b_ada": 0.01 * nrm(ks[5], (DEPTH, 3 * D_MODEL), jnp.float32),
        "g_norm": 1.0 + 0.01 * nrm(ks[6], (DEPTH, D_MODEL), jnp.float32),
        "w_in": nrm(ks[7], (DEPTH, D_MODEL, N_IN), jnp.float32) * (D_MODEL ** -0.5),
        "b_in": b_in,
        "w_conv": nrm(ks[9], (DEPTH, CONV_K, CONV_K, 2 * D_A), jnp.float32) * (1.0 / CONV_K),
        "b_conv": 0.01 * nrm(ks[10], (DEPTH, 2 * D_A), jnp.float32),
        "lb_logits": 0.1 * nrm(ks[11], (DEPTH, D_B), jnp.float32),
        "g_head_a": 1.0 + 0.01 * nrm(ks[12], (DEPTH, D_A), jnp.float32),
        "g_head_b": 1.0 + 0.01 * nrm(ks[13], (DEPTH, D_B), jnp.float32),
        "w_a": nrm(ks[14], (DEPTH, D_A, D_MODEL), jnp.float32) * (D_A ** -0.5),
        "w_b": nrm(ks[15], (DEPTH, D_B, D_MODEL), jnp.float32) * (D_B ** -0.5),
        "w_out": nrm(ks[16], (DEPTH, D_MODEL, D_MODEL), jnp.float32) * (D_MODEL ** -0.5),
        "g_final": 1.0 + 0.01 * nrm(ks[17], (D_MODEL,), jnp.float32),
    }


def reference(x, c, ctx, c_ctx, w_ada, b_ada, g_norm, w_in, b_in, w_conv, b_conv, lb_logits,
              g_head_a, g_head_b, w_a, w_b, w_out, g_final):
    rows = x.shape[1] // GRID_W
    p = jax.nn.softmax(lb_logits.astype(jnp.float32), axis=0)
    lbs = jnp.cumsum(p, axis=0) - p[0:1]
    xc = ctx
    for l in range(DEPTH):
        x, xc = trunk_layer(x, xc, c, c_ctx, w_ada[l], b_ada[l], g_norm[l], w_in[l], b_in[l],
                            w_conv[l], b_conv[l], lbs[l], g_head_a[l], g_head_b[l],
                            w_a[l], w_b[l], w_out[l], rows, l < DEPTH - 1)
    return rmsnorm(x, g_final)
```

```cpp
#include <hip/hip_runtime.h>
#include <hip/hip_cooperative_groups.h>
#include <cstdio>
#include <cstring>
namespace cg = cooperative_groups;

#define LAS __attribute__((address_space(3)))
#define DI __device__ __forceinline__
typedef unsigned short bf16_t;
typedef short bf16x8 __attribute__((ext_vector_type(8)));
typedef short s16x4 __attribute__((ext_vector_type(4)));
typedef float f32x4 __attribute__((ext_vector_type(4)));
typedef unsigned u32x4 __attribute__((ext_vector_type(4)));
typedef unsigned u32x2 __attribute__((ext_vector_type(2)));
typedef LAS unsigned char lds_t;
__device__ __forceinline__ int opaque_tid() { int t = threadIdx.x; asm volatile("" : "+v"(t)); return t; }

namespace pg8 {
constexpr int BM = 256, BK = 64, HALF = 128, HTB = HALF * BK * 2, STAGE_BYTES = 8 * HTB, NXCD = 8, WGM = 8;
__host__ __device__ __forceinline__ int lds_byte(int r, int c) { const int st = (r >> 4) * 2 + (c >> 5), rr = r & 15, cc = c & 31, ob = rr * 64 + cc * 2; return st * 1024 + (ob ^ (((ob >> 9) & 1) << 5)); }
__host__ __device__ __forceinline__ void stage_rc(int b, int& R, int& C) { const int st = b / 1024, sb = b % 1024, swz = sb ^ (((sb >> 9) & 1) << 5); R = (st >> 1) * 16 + swz / 64; C = (st & 1) * 32 + (swz % 64) / 2; }
__host__ __device__ __forceinline__ int perm32(int rho) { const int n = rho >> 4, i = rho & 15; return 8 * (i >> 2) + 4 * n + (i & 3); }
struct Unit { int pm, pn; };
struct Gemm { const bf16_t* A; const bf16_t* Bt; int M, N, K, lda; };
struct StaticOrder {
    int nM, nN, nwg, G, c;
    __host__ __device__ void init(int M, int N, int G_, int c_) { nM = M / BM; nN = N / BM; nwg = nM * nN; G = G_; c = c_; }
    __host__ __device__ bool next(int i, Unit& u) const {
        const long L = (long)i * G + c; if (L >= nwg) return false;
        int wgid = (int)L; { const int q = nwg / NXCD, r = nwg % NXCD, xcd = wgid % NXCD, off = wgid / NXCD; wgid = (xcd < r ? xcd * (q + 1) : r * (q + 1) + (xcd - r) * q) + off; }
        const int nig = WGM * nN, gid = wgid / nig, fm = gid * WGM, gsz = (nM - fm) < WGM ? (nM - fm) : WGM;
        u.pm = fm + ((wgid % nig) % gsz); u.pn = (wgid % nig) / gsz; return true;
    }
    __device__ __forceinline__ void a_ready(const Unit&) const {}
    __device__ __forceinline__ void done(const Unit&) const {}
};
typedef float f32x2_ __attribute__((ext_vector_type(2)));
typedef __bf16 bf16x2_ __attribute__((ext_vector_type(2)));
__device__ __forceinline__ unsigned cvt_pk_bf16(float lo, float hi) { const f32x2_ v = {lo, hi}; const bf16x2_ r = __builtin_convertvector(v, bf16x2_); return __builtin_bit_cast(unsigned, r); }

template <class Epi, class Sched>
__device__ __forceinline__ void gemm_phase(lds_t* lds, const Gemm g, const Sched& S, const Epi& E) {
    const int tid = opaque_tid(), wid = __builtin_amdgcn_readfirstlane(tid >> 6), lane = tid & 63, wr = wid >> 2, wc = wid & 3, fr = lane & 15, fq = lane >> 4;
    const int K = g.K, nt = K / BK, lda = g.lda;
    unsigned voffA[2], voffB[2];
#pragma unroll
    for (int i = 0; i < 2; ++i) { int R, C; stage_rc(tid * 16 + i * 8192, R, C); const int Rb = Epi::PERM ? ((R & ~31) + perm32(R & 31)) : R;
        voffA[i] = (unsigned)(R * lda + C) * 2u; voffB[i] = (unsigned)(Rb * K + C) * 2u; }
    const size_t kstep = (size_t)(BK * 2);
    const size_t hstepA = (size_t)HALF * lda * 2, hstepB = (size_t)HALF * K * 2;
    const size_t tstepA = 2 * hstepA, tstepB = 2 * hstepB;
    const unsigned ldsw = (unsigned)wid * 1024u;
    const int aoff = lds_byte(wr * 64 + fr, fq * 8), boff = lds_byte(wc * 32 + fr, fq * 8);
#define PG8_SA(b, h) (((b) * 2 + (h)) * HTB)
#define PG8_SB(b, h) ((4 + (b) * 2 + (h)) * HTB)
#define PG8_STAGE(bufoff, gbase, voff) do { _Pragma("unroll") for (int _i = 0; _i < 2; ++_i) \
        __builtin_amdgcn_global_load_lds((const unsigned*)((const char*)(gbase) + (voff)[_i]), (LAS unsigned*)(lds + (bufoff) + ldsw + _i * 8192), 16, 0, 0); } while (0)
#define PG8_LDA(dst, b, h) do { _Pragma("unroll") for (int m = 0; m < 4; ++m) _Pragma("unroll") for (int k = 0; k < 2; ++k) dst[m][k] = *(const LAS bf16x8*)(lds + PG8_SA(b, h) + aoff + m * 2048 + k * 1024); } while (0)
#define PG8_LDB(dst, b, h) do { _Pragma("unroll") for (int n = 0; n < 2; ++n) _Pragma("unroll") for (int k = 0; k < 2; ++k) dst[n][k] = *(const LAS bf16x8*)(lds + PG8_SB(b, h) + boff + n * 2048 + k * 1024); } while (0)
#define PG8_MMA(ai, bj, At, Bt) do { __builtin_amdgcn_s_setprio(1); _Pragma("unroll") for (int m = 0; m < 4; ++m) _Pragma("unroll") for (int n = 0; n < 2; ++n) _Pragma("unroll") for (int k = 0; k < 2; ++k) \
        acc[ai][bj][m][n] = __builtin_amdgcn_mfma_f32_16x16x32_bf16(Bt[n][k], At[m][k], acc[ai][bj][m][n], 0, 0, 0); __builtin_amdgcn_s_setprio(0); } while (0)
#define PG8_WAIT_V(n) asm volatile("s_waitcnt vmcnt(" #n ")" ::: "memory")
#define PG8_WAIT_L(n) asm volatile("s_waitcnt lgkmcnt(" #n ")" ::: "memory")
#define PG8_BAR __builtin_amdgcn_s_barrier()
#define PG8_SCHED __builtin_amdgcn_sched_barrier(0)
    Unit cur, nxt; int ui = 0;
    if (!S.next(0, cur)) return;
    f32x4 acc[2][2][4][2];
#pragma unroll
    for (int a = 0; a < 2; ++a)
#pragma unroll
        for (int b = 0; b < 2; ++b)
#pragma unroll
            for (int m = 0; m < 4; ++m)
#pragma unroll
                for (int n = 0; n < 2; ++n) acc[a][b][m][n] = (f32x4){0.f, 0.f, 0.f, 0.f};
    bf16x8 At[4][2], B0[2][2], B1[2][2];
    const char* cA = (const char*)g.A + (size_t)cur.pm * tstepA; const char* cB = (const char*)g.Bt + (size_t)cur.pn * tstepB;
    S.a_ready(cur);
    PG8_STAGE(PG8_SB(0, 0), cB, voffB); PG8_STAGE(PG8_SA(0, 0), cA, voffA); PG8_STAGE(PG8_SB(0, 1), cB + hstepB, voffB); PG8_STAGE(PG8_SA(0, 1), cA + hstepA, voffA);
    if (wr == 1) PG8_BAR;
    PG8_WAIT_V(4); PG8_BAR;
    PG8_STAGE(PG8_SB(1, 0), cB + kstep, voffB); PG8_STAGE(PG8_SA(1, 0), cA + kstep, voffA); PG8_STAGE(PG8_SB(1, 1), cB + hstepB + kstep, voffB);
    PG8_WAIT_V(6); PG8_BAR;
    for (;;) {
        const bool has_next = S.next(ui + 1, nxt);
        const char* nA = has_next ? (const char*)g.A + (size_t)nxt.pm * tstepA : cA; const char* nB = has_next ? (const char*)g.Bt + (size_t)nxt.pn * tstepB : cB;
        for (int t = 0; t < nt; t += 2) {
            const bool last = (t == nt - 2);
            const char* a1 = cA + (size_t)(t + 1) * kstep;
            const char* a2 = last ? nA : cA + (size_t)(t + 2) * kstep; const char* b2 = last ? nB : cB + (size_t)(t + 2) * kstep;
            const char* a3 = a2 + kstep; const char* b3 = b2 + kstep;
            if (last && has_next) S.a_ready(nxt);
            PG8_LDB(B0, 0, 0); PG8_SCHED; PG8_LDA(At, 0, 0); PG8_STAGE(PG8_SA(1, 1), a1 + hstepA, voffA);
            PG8_WAIT_L(8); PG8_BAR; PG8_WAIT_L(0); PG8_MMA(0, 0, At, B0); PG8_BAR; PG8_SCHED;
            PG8_LDB(B1, 0, 1); PG8_STAGE(PG8_SB(0, 0), b2, voffB);
            PG8_BAR; PG8_WAIT_L(0); PG8_MMA(0, 1, At, B1); PG8_BAR;
            PG8_LDA(At, 0, 1); PG8_STAGE(PG8_SA(0, 0), a2, voffA);
            PG8_BAR; PG8_WAIT_L(0); PG8_MMA(1, 0, At, B0); PG8_BAR; PG8_SCHED;
            PG8_STAGE(PG8_SB(0, 1), b2 + hstepB, voffB);
            PG8_WAIT_V(6); PG8_BAR; PG8_MMA(1, 1, At, B1); PG8_BAR;
            PG8_LDB(B0, 1, 0); PG8_SCHED; PG8_LDA(At, 1, 0); PG8_STAGE(PG8_SA(0, 1), a2 + hstepA, voffA);
            PG8_WAIT_L(8); PG8_BAR; PG8_WAIT_L(0); PG8_MMA(0, 0, At, B0); PG8_BAR; PG8_SCHED;
            PG8_LDB(B1, 1, 1); PG8_STAGE(PG8_SB(1, 0), b3, voffB);
            PG8_BAR; PG8_WAIT_L(0); PG8_MMA(0, 1, At, B1); PG8_BAR;
            PG8_LDA(At, 1, 1); PG8_STAGE(PG8_SA(1, 0), a3, voffA);
            PG8_BAR; PG8_WAIT_L(0); PG8_MMA(1, 0, At, B0); PG8_BAR; PG8_SCHED;
            PG8_STAGE(PG8_SB(1, 1), b3 + hstepB, voffB);
            PG8_WAIT_V(6); PG8_BAR; PG8_MMA(1, 1, At, B1); PG8_BAR;
        }
        E(acc, cur, wr, wc, fr, fq); S.done(cur);
        if (!has_next) break;
#pragma unroll
        for (int a = 0; a < 2; ++a)
#pragma unroll
            for (int b = 0; b < 2; ++b)
#pragma unroll
                for (int m = 0; m < 4; ++m)
#pragma unroll
                    for (int n = 0; n < 2; ++n) acc[a][b][m][n] = (f32x4){0.f, 0.f, 0.f, 0.f};
        cur = nxt; cA = nA; cB = nB; ++ui;
    }
    PG8_WAIT_V(0);
    if (wr == 0) PG8_BAR;
    PG8_BAR;
#undef PG8_SA
#undef PG8_SB
#undef PG8_STAGE
#undef PG8_LDA
#undef PG8_LDB
#undef PG8_MMA
#undef PG8_WAIT_V
#undef PG8_WAIT_L
#undef PG8_BAR
#undef PG8_SCHED
}
}

constexpr int DM = 1024, NB = 2, SEQ = 16384, DEPTH = 4, CTX = 256, NIN_W = 12304;
constexpr int MB = CTX + SEQ;
constexpr int NSC = MB / 256;
constexpr int PW = 12288;
constexpr int NPAD = 12544;
constexpr int PC_QK = 0, PC_V = 2048, PC_O = 3072, PC_ZA = 4096, PC_QB = 5120, PC_IB = 6144, PC_FF = 7168, PC_FB = 8192, PC_ZB = 9216, PC_MA = 10240, PC_MB = 11264;
constexpr int PC_OF = 0, PC_OB = 1024;
constexpr float EPS = 1e-6f;
constexpr size_t GS = (size_t)(CTX + SEQ) * 1024;
#define PG(c) ((size_t)((c) >> 10) * GS)

constexpr size_t al256(size_t x) { return (x + 255) & ~(size_t)255; }
constexpr size_t OFF_P = 0;
constexpr size_t OFF_QKC = OFF_P + al256((size_t)MB * PW * 2);
constexpr size_t OFF_HA = OFF_QKC + al256((size_t)MB * 2048 * 2);
constexpr size_t OFF_G = OFF_HA + al256((size_t)MB * DM * 2);
constexpr size_t OFF_BTIN = OFF_G + al256((size_t)MB * 16 * 4);
constexpr size_t OFF_BTA = OFF_BTIN + al256((size_t)NPAD * DM * 2);
constexpr size_t OFF_BTB = OFF_BTA + al256((size_t)DM * DM * 2);
constexpr size_t OFF_BTO = OFF_BTB + al256((size_t)DM * DM * 2);
constexpr size_t OFF_BIAS = OFF_BTO + al256((size_t)DM * DM * 2);
constexpr size_t OFF_STA = OFF_BIAS + al256((size_t)NPAD * 4);
constexpr size_t OFF_NST = OFF_STA + al256((size_t)8 * NSC * 65536 * 2);
constexpr size_t OFF_SCA = OFF_NST + al256((size_t)8 * NSC * 256 * 4);
constexpr size_t OFF_STB = OFF_SCA + 8192;
constexpr size_t OFF_GSUM = OFF_STB + al256((size_t)16 * NSC * 16384 * 2);
constexpr size_t OFF_XC = OFF_GSUM + al256((size_t)16 * NSC * 128 * 4);
constexpr size_t OFF_MOD = OFF_XC + al256((size_t)NB * CTX * DM * 4);
constexpr size_t OFF_HB2 = OFF_MOD + al256((size_t)DEPTH * 3 * 3072 * 4);
constexpr size_t WS_END = OFF_HB2 + al256((size_t)MB * DM * 2);

constexpr int LDS_BYTES = 147456;

struct Params {
    const float *x, *c, *ctx, *c_ctx, *w_ada, *b_ada, *g_norm, *w_in, *b_in, *w_conv, *b_conv, *lb_logits, *g_head_a, *g_head_b, *w_a, *w_b, *w_out, *g_final;
    float* out; unsigned char* ws;
};

typedef const __attribute__((address_space(4))) Params* kparams_t;
DI float bf2f(unsigned short b) { return __uint_as_float(((unsigned)b) << 16); }
DI float bflo(unsigned w) { return __uint_as_float(w << 16); }
DI float bfhi(unsigned w) { return __uint_as_float(w & 0xffff0000u); }
DI unsigned pk2(float lo, float hi) { return pg8::cvt_pk_bf16(lo, hi); }
DI unsigned short f2bf(float f) { return (unsigned short)(pk2(f, 0.f) & 0xffffu); }
DI int lane_id_op() { int l = (int)__builtin_amdgcn_mbcnt_hi(~0u, __builtin_amdgcn_mbcnt_lo(~0u, 0u)); asm volatile("" : "+v"(l)); return l; }
DI float shx(float v, int o) { return __builtin_bit_cast(float, __builtin_amdgcn_ds_bpermute((lane_id_op() ^ o) << 2, __builtin_bit_cast(int, v))); }
DI float shup(float v, int o) { const int l = lane_id_op(); const int src = l >= o ? l - o : l; return __builtin_bit_cast(float, __builtin_amdgcn_ds_bpermute(src << 2, __builtin_bit_cast(int, v))); }
DI float rdlane63(float v) { return __builtin_bit_cast(float, __builtin_amdgcn_readlane(__builtin_bit_cast(int, v), 63)); }
DI float wave_sum(float v) {
#pragma unroll
    for (int o = 1; o < 64; o <<= 1) v += shx(v, o);
    return v;
}
DI float wave_max(float v) {
#pragma unroll
    for (int o = 1; o < 64; o <<= 1) v = fmaxf(v, shx(v, o));
    return v;
}
DI float sigmoidf_(float x) { return 1.0f / (1.0f + __expf(-x)); }
DI float siluf_(float x) { return x / (1.0f + __expf(-x)); }
DI float logsigmoidf_(float x) { return fminf(x, 0.f) - log1pf(__expf(-fabsf(x))); }
DI bf16x8 mk8(s16x4 a, s16x4 b) { bf16x8 r; r[0] = a[0]; r[1] = a[1]; r[2] = a[2]; r[3] = a[3]; r[4] = b[0]; r[5] = b[1]; r[6] = b[2]; r[7] = b[3]; return r; }
DI s16x4 trrd(lds_t* p) { return __builtin_amdgcn_ds_read_tr16_b64_v4i16((LAS s16x4*)p); }
DI bf16x8 pack8(f32x4 a, f32x4 b) { u32x4 w; w.x = pk2(a[0], a[1]); w.y = pk2(a[2], a[3]); w.z = pk2(b[0], b[1]); w.w = pk2(b[2], b[3]); return __builtin_bit_cast(bf16x8, w); }
#define MFMA16(a, b, c) __builtin_amdgcn_mfma_f32_16x16x32_bf16(a, b, c, 0, 0, 0)

struct EpiIn {
    static constexpr bool PERM = true, AFTER_DRAIN = false;
    bf16_t* P; float* G; const float* bias;
    DI void operator()(const f32x4 (&acc)[2][2][4][2], const pg8::Unit& u, int wr, int wc, int fr, int fq) const {
        const int row0 = u.pm * 256 + wr * 64 + fr, col0 = u.pn * 256 + wc * 32 + 8 * fq;
        f32x4 bv[2][2];
#pragma unroll
        for (int bj = 0; bj < 2; ++bj)
#pragma unroll
            for (int n = 0; n < 2; ++n) bv[bj][n] = *(const f32x4*)(bias + col0 + bj * 128 + 4 * n);
        if (u.pn < 48) {
#pragma unroll
            for (int ai = 0; ai < 2; ++ai)
#pragma unroll
                for (int m = 0; m < 4; ++m) { bf16_t* rowp = P + (size_t)(u.pn >> 2) * GS + (size_t)(row0 + ai * 128 + m * 16) * 1024 + (col0 & 1023);
#pragma unroll
                    for (int bj = 0; bj < 2; ++bj) { const f32x4 v0 = acc[ai][bj][m][0] + bv[bj][0], v1 = acc[ai][bj][m][1] + bv[bj][1];
                        u32x4 w; w.x = pk2(v0[0], v0[1]); w.y = pk2(v0[2], v0[3]); w.z = pk2(v1[0], v1[1]); w.w = pk2(v1[2], v1[3]);
                        *(u32x4*)(rowp + bj * 128) = w; } }
        } else if (wc == 0 && fq < 2) {
#pragma unroll
            for (int ai = 0; ai < 2; ++ai)
#pragma unroll
                for (int m = 0; m < 4; ++m) { float* gp = G + (size_t)(row0 + ai * 128 + m * 16) * 16 + 8 * fq;
                    *(f32x4*)gp = acc[ai][0][m][0] + bv[0][0]; *(f32x4*)(gp + 4) = acc[ai][0][m][1] + bv[0][1]; }
        }
    }
};
template <int SECOND> struct EpiMerge {
    static constexpr bool PERM = true, AFTER_DRAIN = false;
    const bf16_t* P; bf16_t* Y;
    DI void operator()(const f32x4 (&acc)[2][2][4][2], const pg8::Unit& u, int wr, int wc, int fr, int fq) const {
        const int row0 = CTX + u.pm * 256 + wr * 64 + fr, col0 = u.pn * 256 + wc * 32 + 8 * fq;
#pragma unroll
        for (int ai = 0; ai < 2; ++ai)
#pragma unroll
            for (int m = 0; m < 4; ++m) { const size_t row = (size_t)(row0 + ai * 128 + m * 16);
#pragma unroll
                for (int bj = 0; bj < 2; ++bj) { const int col = col0 + bj * 128;
                    const u32x4 mg = *(const u32x4*)(P + PG(SECOND ? PC_MB : PC_MA) + row * 1024 + col);
                    f32x4 v0 = acc[ai][bj][m][0], v1 = acc[ai][bj][m][1];
                    v0[0] *= sigmoidf_(bflo(mg.x)); v0[1] *= sigmoidf_(bfhi(mg.x)); v0[2] *= sigmoidf_(bflo(mg.y)); v0[3] *= sigmoidf_(bfhi(mg.y));
                    v1[0] *= sigmoidf_(bflo(mg.z)); v1[1] *= sigmoidf_(bfhi(mg.z)); v1[2] *= sigmoidf_(bflo(mg.w)); v1[3] *= sigmoidf_(bfhi(mg.w));
                    bf16_t* yp = Y + row * DM + col;
                    if (SECOND) { const u32x4 o = *(const u32x4*)yp;
                        v0[0] += bflo(o.x); v0[1] += bfhi(o.x); v0[2] += bflo(o.y); v0[3] += bfhi(o.y);
                        v1[0] += bflo(o.z); v1[1] += bfhi(o.z); v1[2] += bflo(o.w); v1[3] += bfhi(o.w); }
                    u32x4 w; w.x = pk2(v0[0], v0[1]); w.y = pk2(v0[2], v0[3]); w.z = pk2(v1[0], v1[1]); w.w = pk2(v1[2], v1[3]);
                    *(u32x4*)yp = w; } }
    }
};
struct EpiOut {
    static constexpr bool PERM = false, AFTER_DRAIN = false;
    const float* xl_src; float* xl_dst; const float* gate_lat;
    DI void operator()(const f32x4 (&acc)[2][2][4][2], const pg8::Unit& u, int wr, int wc, int fr, int fq) const {
        const int row0 = u.pm * 256 + wr * 64 + fr, col0 = u.pn * 256 + wc * 32 + 4 * fq;
        f32x4 gv[2][2];
#pragma unroll
        for (int bj = 0; bj < 2; ++bj)
#pragma unroll
            for (int n = 0; n < 2; ++n) gv[bj][n] = *(const f32x4*)(gate_lat + col0 + bj * 128 + n * 16);
#pragma unroll
        for (int ai = 0; ai < 2; ++ai)
#pragma unroll
            for (int m = 0; m < 4; ++m) { const size_t off = (size_t)(row0 + ai * 128 + m * 16) * DM + col0;
#pragma unroll
                for (int bj = 0; bj < 2; ++bj)
#pragma unroll
                    for (int n = 0; n < 2; ++n) { const f32x4 xo = *(const f32x4*)(xl_src + off + bj * 128 + n * 16);
                        *(f32x4*)(xl_dst + off + bj * 128 + n * 16) = xo + gv[bj][n] * acc[ai][bj][m][n]; } }
    }
};
template <int MODE> DI void ctx_patch(lds_t* L, const bf16_t* A0, const bf16_t* B0t, const bf16_t* A1, const bf16_t* B1t, const bf16_t* Ma, const bf16_t* Mb, bf16_t* Y,
                                      const float* xsrc, float* xdst, const float* gate) {
    const int tid = opaque_tid(), wid = tid >> 6, lane = tid & 63, g = lane >> 4, l15 = lane & 15;
    constexpr int NP = MODE == 0 ? 2 : 1;
    for (int patch = blockIdx.x; patch < 256; patch += gridDim.x) {
        const int pr = patch >> 5, pc = patch & 31;
        f32x4 acc[NP][2][2];
#pragma unroll
        for (int part = 0; part < NP; ++part) {
            const bf16_t* A = part ? A1 : A0; const bf16_t* Bt = part ? B1t : B0t;
            bf16x8 Af[2][4], Bf[2][4];
#pragma unroll
            for (int t2 = 0; t2 < 2; ++t2)
#pragma unroll
                for (int ks = 0; ks < 4; ++ks) { Af[t2][ks] = *(const bf16x8*)(A + (size_t)(32 * pr + 16 * t2 + l15) * 1024 + 128 * wid + 32 * ks + 8 * g);
                    Bf[t2][ks] = *(const bf16x8*)(Bt + (size_t)(32 * pc + 16 * t2 + l15) * 1024 + 128 * wid + 32 * ks + 8 * g); }
#pragma unroll
            for (int tm = 0; tm < 2; ++tm)
#pragma unroll
                for (int tn = 0; tn < 2; ++tn) { f32x4 a = (f32x4){0.f, 0.f, 0.f, 0.f};
#pragma unroll
                    for (int ks = 0; ks < 4; ++ks) a = MFMA16(Bf[tn][ks], Af[tm][ks], a);
                    acc[part][tm][tn] = a; }
        }
        __syncthreads();
        LAS f32x4* red = (LAS f32x4*)L;
#pragma unroll
        for (int part = 0; part < NP; ++part)
#pragma unroll
            for (int tm = 0; tm < 2; ++tm)
#pragma unroll
                for (int tn = 0; tn < 2; ++tn) red[((part * 8 + wid) * 4 + tm * 2 + tn) * 64 + lane] = acc[part][tm][tn];
        __syncthreads();
        if (tid < 256) {
            const int tile = tid >> 6, ln = tid & 63, tm = tile >> 1, tn = tile & 1;
            f32x4 s0 = (f32x4){0.f, 0.f, 0.f, 0.f}, s1 = s0;
#pragma unroll
            for (int w = 0; w < 8; ++w) { s0 += red[(w * 4 + tile) * 64 + ln]; if (MODE == 0) s1 += red[((8 + w) * 4 + tile) * 64 + ln]; }
            const size_t off = (size_t)(32 * pr + 16 * tm + (ln & 15)) * 1024 + 32 * pc + 16 * tn + 4 * (ln >> 4);
            if (MODE == 0) { const u32x2 ma = *(const u32x2*)(Ma + off), mb = *(const u32x2*)(Mb + off);
                const float y0 = sigmoidf_(bflo(ma.x)) * s0[0] + sigmoidf_(bflo(mb.x)) * s1[0], y1 = sigmoidf_(bfhi(ma.x)) * s0[1] + sigmoidf_(bfhi(mb.x)) * s1[1];
                const float y2 = sigmoidf_(bflo(ma.y)) * s0[2] + sigmoidf_(bflo(mb.y)) * s1[2], y3 = sigmoidf_(bfhi(ma.y)) * s0[3] + sigmoidf_(bfhi(mb.y)) * s1[3];
                u32x2 w; w.x = pk2(y0, y1); w.y = pk2(y2, y3); *(u32x2*)(Y + off) = w; }
            else { const f32x4 xo = *(const f32x4*)(xsrc + off), gv = *(const f32x4*)(gate + 32 * pc + 16 * tn + 4 * (ln >> 4)); *(f32x4*)(xdst + off) = xo + gv * s0; }
        }
        __syncthreads();
    }
}

DI void phase_ada(kparams_t p, lds_t* L, float* mod) {
    const int tid = opaque_tid(), wid = tid >> 6, lane = tid & 63;
    LAS float* sc = (LAS float*)L; LAS float* red = sc + 3072;
    for (int i = tid; i < 3072; i += 512) { const int v = i >> 10, k = i & 1023; const float c = (v < 2) ? p->c[v * 1024 + k] : p->c_ctx[k]; sc[i] = siluf_(c); }
    __syncthreads();
    for (int it = blockIdx.x; it < DEPTH * 48; it += gridDim.x) {
        const int l = it / 48, cgp = it % 48, n = cgp * 64 + lane;
        const float* W = p->w_ada + (size_t)l * 1024 * 3072 + n;
        float a0 = 0.f, a1 = 0.f, a2 = 0.f;
#pragma unroll 8
        for (int kk = 0; kk < 128; ++kk) { const int k = wid * 128 + kk; const float w = W[(size_t)k * 3072]; a0 += sc[k] * w; a1 += sc[1024 + k] * w; a2 += sc[2048 + k] * w; }
        red[(wid * 3 + 0) * 64 + lane] = a0; red[(wid * 3 + 1) * 64 + lane] = a1; red[(wid * 3 + 2) * 64 + lane] = a2;
        __syncthreads();
        if (tid < 192) { const int v = tid >> 6, ln = tid & 63; float s = 0.f;
#pragma unroll
            for (int w = 0; w < 8; ++w) s += red[(w * 3 + v) * 64 + ln];
            const int nn = cgp * 64 + ln; mod[(l * 3 + v) * 3072 + nn] = s + p->b_ada[l * 3072 + nn]; }
        __syncthreads();
    }
}

DI void transpose_item(const float* W, int ldw, int k0, int c0, bf16_t* WT, int n0, LAS float* scr, int lane) {
#pragma unroll 8
    for (int i = 0; i < 32; ++i) { const int kk = 2 * i + (lane >> 5); scr[kk * 33 + (lane & 31)] = W[(size_t)(k0 + kk) * ldw + c0 + (lane & 31)]; }
    asm volatile("s_waitcnt lgkmcnt(0)" ::: "memory");
    const int c = lane & 7;
#pragma unroll
    for (int j = 0; j < 4; ++j) { const int n = (lane >> 3) + 8 * j; const LAS float* s = scr + (8 * c) * 33 + n;
        u32x4 o; o.x = pk2(s[0 * 33], s[1 * 33]); o.y = pk2(s[2 * 33], s[3 * 33]); o.z = pk2(s[4 * 33], s[5 * 33]); o.w = pk2(s[6 * 33], s[7 * 33]);
        *(u32x4*)(WT + (size_t)(n0 + n) * 1024 + k0 + 8 * c) = o; }
    asm volatile("s_waitcnt lgkmcnt(0)" ::: "memory");
}
DI void phase_wconv(kparams_t p, lds_t* L, int l, bf16_t* BtIn, bf16_t* BtA, bf16_t* BtB, bf16_t* BtO, float* bias2) {
    const int tid = opaque_tid(), wid = tid >> 6, lane = tid & 63;
    LAS float* scr = (LAS float*)(L + wid * 8448);
    const float* Win = p->w_in + (size_t)l * 1024 * NIN_W;
    const int gw = blockIdx.x * 8 + wid, NGW = gridDim.x * 8;
    constexpr int I_IN = 384 * 16, I_SQ = 32 * 16;
    for (int it = gw; it < I_IN + 3 * I_SQ; it += NGW) {
        if (it < I_IN) { const int nb = it >> 4, kb = it & 15, n0 = 32 * nb; transpose_item(Win, NIN_W, 64 * kb, n0 < 5120 ? n0 : n0 + 16, BtIn, n0, scr, lane); }
        else { int r = it - I_IN; const int m = r / I_SQ; r -= m * I_SQ; const int nb = r >> 4, kb = r & 15;
            const float* W = (m == 0 ? p->w_a : m == 1 ? p->w_b : p->w_out) + (size_t)l * 1024 * 1024; bf16_t* WT = m == 0 ? BtA : m == 1 ? BtB : BtO;
            transpose_item(W, 1024, 64 * kb, 32 * nb, WT, 32 * nb, scr, lane); }
    }
    const int gt = blockIdx.x * 512 + tid, NGT = gridDim.x * 512;
    for (int i = gt; i < 256 * 1024; i += NGT) { const int n = 12288 + (i >> 10), k = i & 1023; const float v = (n < 12304) ? Win[(size_t)k * NIN_W + 5120 + (n - 12288)] : 0.f; BtIn[(size_t)n * 1024 + k] = f2bf(v); }
    const float* bi = p->b_in + (size_t)l * NIN_W;
    for (int i = gt; i < NPAD; i += NGT) bias2[i] = i < 5120 ? bi[i] : i < 12288 ? bi[i + 16] : i < 12304 ? bi[5120 + i - 12288] : 0.f;
}

DI void phase_norm(kparams_t p, int l, int b, const float* xl, const float* xc, const float* mod, bf16_t* hA) {
    const int tid_ = opaque_tid(), wid = tid_ >> 6, lane = tid_ & 63;
    const float* gn = p->g_norm + l * 1024;
    for (int r = blockIdx.x * 8 + wid; r < MB; r += gridDim.x * 8) {
        const float* src = r < 256 ? xc + (size_t)r * DM : xl + (size_t)(r - 256) * DM;
        const float* md = mod + (l * 3 + (r < 256 ? 2 : b)) * 3072;
        f32x4 v[4]; float s = 0.f;
#pragma unroll
        for (int j = 0; j < 4; ++j) { v[j] = *(const f32x4*)(src + 4 * lane + 256 * j); s += v[j][0] * v[j][0] + v[j][1] * v[j][1] + v[j][2] * v[j][2] + v[j][3] * v[j][3]; }
        const float rs = rsqrtf(wave_sum(s) * (1.f / DM) + EPS);
#pragma unroll
        for (int j = 0; j < 4; ++j) { const int i = 4 * lane + 256 * j;
            const f32x4 g = *(const f32x4*)(gn + i), sh = *(const f32x4*)(md + i), scl = *(const f32x4*)(md + 1024 + i);
            const f32x4 y = (v[j] * rs * g) * (scl + 1.0f) + sh;
            u32x2 w; w.x = pk2(y[0], y[1]); w.y = pk2(y[2], y[3]); *(u32x2*)(hA + (size_t)r * DM + i) = w; }
    }
}

DI void phase_conv(kparams_t p, int l, const bf16_t* P, bf16_t* QKc) {
    const int tid = opaque_tid(), cgp = tid & 255, sub = tid >> 8, c0 = 8 * cgp;
    const float* wc = p->w_conv + (size_t)l * 9 * 2048 + c0; const float* bc = p->b_conv + l * 2048 + c0;
    float w[9][8], bias[8];
#pragma unroll
    for (int a = 0; a < 9; ++a) { const f32x4 lo = *(const f32x4*)(wc + a * 2048), hi = *(const f32x4*)(wc + a * 2048 + 4);
#pragma unroll
        for (int i = 0; i < 4; ++i) { w[a][i] = lo[i]; w[a][4 + i] = hi[i]; } }
    { const f32x4 lo = *(const f32x4*)bc, hi = *(const f32x4*)(bc + 4);
#pragma unroll
      for (int i = 0; i < 4; ++i) { bias[i] = lo[i]; bias[4 + i] = hi[i]; } }
    const float oscale = c0 >= 1024 ? 0.0625f : 1.0f;
    for (int rp = blockIdx.x; rp < MB / 2; rp += gridDim.x) {
        const int r = 2 * rp + sub;
        float acc[8];
#pragma unroll
        for (int i = 0; i < 8; ++i) acc[i] = bias[i];
        if (r >= 256) {
            const int t = r - 256, y = t >> 6, x = t & 63;
            u32x4 uu[9]; float wm[9];
#pragma unroll
            for (int a = 0; a < 3; ++a)
#pragma unroll
                for (int bb = 0; bb < 3; ++bb) { const int yy = y + a - 1, xx = x + bb - 1; const bool ok = yy >= 0 && yy < 256 && xx >= 0 && xx < 64;
                    const int yc = min(max(yy, 0), 255), xc = min(max(xx, 0), 63);
                    uu[a * 3 + bb] = *(const u32x4*)(P + PG(c0) + (size_t)(256 + yc * 64 + xc) * 1024 + (c0 & 1023)); wm[a * 3 + bb] = ok ? 1.f : 0.f; }
#pragma unroll
            for (int k = 0; k < 9; ++k) { const u32x4 u = uu[k]; const float m = wm[k];
                acc[0] += (w[k][0] * m) * bflo(u.x); acc[1] += (w[k][1] * m) * bfhi(u.x); acc[2] += (w[k][2] * m) * bflo(u.y); acc[3] += (w[k][3] * m) * bfhi(u.y);
                acc[4] += (w[k][4] * m) * bflo(u.z); acc[5] += (w[k][5] * m) * bfhi(u.z); acc[6] += (w[k][6] * m) * bflo(u.w); acc[7] += (w[k][7] * m) * bfhi(u.w); }
        } else {
#pragma unroll
            for (int bb = 0; bb < 3; ++bb) { const int tt = r + bb - 1;
                if (tt >= 0 && tt < 256) { const u32x4 u = *(const u32x4*)(P + PG(c0) + (size_t)tt * 1024 + (c0 & 1023));
                    acc[0] += w[3 + bb][0] * bflo(u.x); acc[1] += w[3 + bb][1] * bfhi(u.x); acc[2] += w[3 + bb][2] * bflo(u.y); acc[3] += w[3 + bb][3] * bfhi(u.y);
                    acc[4] += w[3 + bb][4] * bflo(u.z); acc[5] += w[3 + bb][5] * bfhi(u.z); acc[6] += w[3 + bb][6] * bflo(u.w); acc[7] += w[3 + bb][7] * bfhi(u.w); } }
        }
#pragma unroll
        for (int i = 0; i < 8; ++i) acc[i] = siluf_(acc[i]) * oscale;
        u32x4 o; o.x = pk2(acc[0], acc[1]); o.y = pk2(acc[2], acc[3]); o.z = pk2(acc[4], acc[5]); o.w = pk2(acc[6], acc[7]);
        *(u32x4*)(QKc + (size_t)r * 2048 + c0) = o;
    }
}

DI void phase_post(kparams_t p, int l, bf16_t* P, const bf16_t* HF, const bf16_t* HB) {
    const int tid_ = opaque_tid(), wid = tid_ >> 6, lane = tid_ & 63;
    const float* ga = p->g_head_a + l * 1024; const float* gb = p->g_head_b + l * 1024;
    for (int r = blockIdx.x * 8 + wid; r < MB; r += gridDim.x * 8) {
        bf16_t* pr = P + (size_t)r * 1024;
        u32x2 ahf[4], ahb[4], aog[4], azz[4], bhf[4], bhb[4], bzz[4];
#pragma unroll
        for (int h = 0; h < 4; ++h) { const int c4 = 256 * h + 4 * lane;
            ahf[h] = *(const u32x2*)(HF + (size_t)r * 1024 + c4); ahb[h] = *(const u32x2*)(HB + (size_t)r * 1024 + c4); aog[h] = *(const u32x2*)(pr + PG(PC_O) + c4); azz[h] = *(const u32x2*)(pr + PG(PC_ZA) + c4);
            bhf[h] = *(const u32x2*)(pr + PG(PC_OF) + c4); bhb[h] = *(const u32x2*)(pr + PG(PC_OB) + c4); bzz[h] = *(const u32x2*)(pr + PG(PC_ZB) + c4); }
#pragma unroll
        for (int h = 0; h < 4; ++h) { const int c4 = 256 * h + 4 * lane;
            const u32x2 hf = ahf[h], hb = ahb[h], og = aog[h], zz = azz[h];
            float hh[4] = {(bflo(hf.x) + bflo(hb.x)) * sigmoidf_(bflo(og.x)), (bfhi(hf.x) + bfhi(hb.x)) * sigmoidf_(bfhi(og.x)), (bflo(hf.y) + bflo(hb.y)) * sigmoidf_(bflo(og.y)), (bfhi(hf.y) + bfhi(hb.y)) * sigmoidf_(bfhi(og.y))};
            const float rs = rsqrtf(wave_sum(hh[0] * hh[0] + hh[1] * hh[1] + hh[2] * hh[2] + hh[3] * hh[3]) * (1.f / 256.f) + EPS);
            const f32x4 g = *(const f32x4*)(ga + c4);
            const float z[4] = {bflo(zz.x), bfhi(zz.x), bflo(zz.y), bfhi(zz.y)};
            float y[4];
#pragma unroll
            for (int i = 0; i < 4; ++i) y[i] = hh[i] * rs * g[i] * siluf_(z[i]);
            u32x2 w; w.x = pk2(y[0], y[1]); w.y = pk2(y[2], y[3]); *(u32x2*)(pr + PG(PC_O) + c4) = w; }
#pragma unroll
        for (int hp = 0; hp < 4; ++hp) { const int c4 = 256 * hp + 4 * lane;
            const u32x2 hf = bhf[hp], hb = bhb[hp], zz = bzz[hp];
            float hh[4] = {bflo(hf.x) + bflo(hb.x), bfhi(hf.x) + bfhi(hb.x), bflo(hf.y) + bflo(hb.y), bfhi(hf.y) + bfhi(hb.y)};
            float s = hh[0] * hh[0] + hh[1] * hh[1] + hh[2] * hh[2] + hh[3] * hh[3];
#pragma unroll
            for (int o = 1; o < 32; o <<= 1) s += shx(s, o);
            const float rs = rsqrtf(s * (1.f / 128.f) + EPS);
            const f32x4 g = *(const f32x4*)(gb + c4);
            const float z[4] = {bflo(zz.x), bfhi(zz.x), bflo(zz.y), bfhi(zz.y)};
            float y[4];
#pragma unroll
            for (int i = 0; i < 4; ++i) y[i] = hh[i] * rs * g[i] * siluf_(z[i]);
            u32x2 w; w.x = pk2(y[0], y[1]); w.y = pk2(y[2], y[3]); *(u32x2*)(pr + PG(PC_ZB) + c4) = w; }
    }
}

DI void phase_final(kparams_t p, float* out) {
    const int tid_ = opaque_tid(), wid = tid_ >> 6, lane = tid_ & 63;
    for (int r = blockIdx.x * 8 + wid; r < NB * SEQ; r += gridDim.x * 8) {
        float* row = out + (size_t)r * DM; f32x4 v[4]; float s = 0.f;
#pragma unroll
        for (int j = 0; j < 4; ++j) { v[j] = *(const f32x4*)(row + 4 * lane + 256 * j); s += v[j][0] * v[j][0] + v[j][1] * v[j][1] + v[j][2] * v[j][2] + v[j][3] * v[j][3]; }
        const float rs = rsqrtf(wave_sum(s) * (1.f / DM) + EPS);
#pragma unroll
        for (int j = 0; j < 4; ++j) { const f32x4 g = *(const f32x4*)(p->g_final + 4 * lane + 256 * j); *(f32x4*)(row + 4 * lane + 256 * j) = v[j] * rs * g; }
    }
}

DI int sc_order(int d, int j) { return d == 0 ? j : (j == 0 ? 0 : NSC - j); }
constexpr int KST = 528;
constexpr int ML_BUFK = 0, ML_BUFV = 64 * KST, ML_F0 = 2 * 64 * KST, ML_F1 = ML_F0 + 1024, ML_F2 = ML_F1 + 1024, ML_F3 = ML_F2 + 1024;

template <int MODE> DI void mlstm_scalars(const float* G, int row0, int h, int d, float m_in, lds_t* L, float& Bout, float& mout) {
    const int lane = opaque_tid() & 63;
    LAS float* F0 = (LAS float*)(L + ML_F0); LAS float* F1 = (LAS float*)(L + ML_F1); LAS float* F2 = (LAS float*)(L + ML_F2);
    float li[4], bb[4]; int rr[4]; float run = 0.f;
#pragma unroll
    for (int i = 0; i < 4; ++i) { const int pp = 4 * lane + i; rr[i] = d ? 255 - pp : pp; const float* gr = G + (size_t)(row0 + rr[i]) * 16;
        li[i] = gr[(2 * d) * 4 + h]; run += logsigmoidf_(gr[(2 * d + 1) * 4 + h]); bb[i] = run; }
    float incl = run;
#pragma unroll
    for (int o = 1; o < 64; o <<= 1) { const float v = shup(incl, o); if (lane >= o) incl += v; }
    const float excl = incl - run; const float B = rdlane63(incl);
#pragma unroll
    for (int i = 0; i < 4; ++i) bb[i] += excl;
    if (MODE == 0) {
        float ws[4], mx = -3.0e38f;
#pragma unroll
        for (int i = 0; i < 4; ++i) { ws[i] = B - bb[i] + li[i]; mx = fmaxf(mx, ws[i]); }
        mx = wave_max(mx);
#pragma unroll
        for (int i = 0; i < 4; ++i) F0[rr[i]] = __expf(ws[i] - mx);
        Bout = B; mout = mx;
    } else {
        float u[4], pm[4], mx = -3.0e38f;
#pragma unroll
        for (int i = 0; i < 4; ++i) { u[i] = li[i] - bb[i]; mx = fmaxf(mx, u[i]); pm[i] = mx; }
        float inc = mx;
#pragma unroll
        for (int o = 1; o < 64; o <<= 1) { const float v = shup(inc, o); if (lane >= o) inc = fmaxf(inc, v); }
        float ex = shup(inc, 1); if (lane == 0) ex = -3.0e38f;
#pragma unroll
        for (int i = 0; i < 4; ++i) { F0[rr[i]] = u[i]; F1[rr[i]] = fmaxf(m_in, fmaxf(ex, pm[i])); F2[rr[i]] = bb[i]; }
        Bout = B; mout = 0.f;
    }
}

DI void mlstm_passA(int item, lds_t* L, const bf16_t* P, const bf16_t* QKc, const float* G, bf16_t* STA, float* NST, float* SCA) {
    const int tid = opaque_tid(), wid = tid >> 6, lane = tid & 63, g = lane >> 4, q4 = (lane >> 2) & 3, p4 = lane & 3, l15 = lane & 15;
    const int j = item % NSC, hd = item / NSC, d = hd & 1, h = hd >> 1, scan = hd, o = sc_order(d, j), row0 = 256 * j;
    constexpr int A_PAIR = 2 * 64 * KST, A_SCAL = 2 * A_PAIR;
    lds_t* LS = L + (A_SCAL - ML_F0);
    u32x4 pk[4], pv[4];
#define MA_LOAD(sb_) do { _Pragma("unroll") for (int it = 0; it < 4; ++it) { const int c = tid + 512 * it, r = c >> 5, c16 = c & 31; const size_t grow = (size_t)(row0 + 64 * (sb_) + r); \
        pk[it] = *(const u32x4*)(QKc + grow * 2048 + 1024 + 256 * h + 8 * c16); pv[it] = *(const u32x4*)(P + PG(PC_V) + grow * 1024 + 256 * h + 8 * c16); } } while (0)
    MA_LOAD(0);
    __syncthreads();
    if (wid == 0) { float Bv, mv; mlstm_scalars<0>(G, row0, h, d, 0.f, LS, Bv, mv); if (lane == 0) { SCA[scan * NSC + o] = Bv; SCA[520 + scan * NSC + o] = mv; } }
    __syncthreads();
    LAS float* WSE = (LAS float*)(LS + ML_F0);
    f32x4 acc[2][16];
#pragma unroll
    for (int a = 0; a < 2; ++a)
#pragma unroll
        for (int n = 0; n < 16; ++n) acc[a][n] = (f32x4){0.f, 0.f, 0.f, 0.f};
    f32x4 nacc[2] = {(f32x4){0.f, 0.f, 0.f, 0.f}, (f32x4){0.f, 0.f, 0.f, 0.f}};
    bf16x8 ones;
#pragma unroll
    for (int i = 0; i < 8; ++i) ones[i] = (short)0x3F80;
    for (int sb = 0; sb < 4; ++sb) {
        const int pb = (sb & 1) * A_PAIR;
#pragma unroll
        for (int it = 0; it < 4; ++it) { const int c = tid + 512 * it, r = c >> 5, c16 = c & 31;
            const u32x4 kv = pk[it]; const float w = WSE[64 * sb + r];
            u32x4 ko; ko.x = pk2(bflo(kv.x) * w, bfhi(kv.x) * w); ko.y = pk2(bflo(kv.y) * w, bfhi(kv.y) * w); ko.z = pk2(bflo(kv.z) * w, bfhi(kv.z) * w); ko.w = pk2(bflo(kv.w) * w, bfhi(kv.w) * w);
            *(LAS u32x4*)(L + pb + ML_BUFK + r * KST + 16 * c16) = ko; *(LAS u32x4*)(L + pb + ML_BUFV + r * KST + 16 * c16) = pv[it]; }
        __syncthreads();
        if (sb < 3) MA_LOAD(sb + 1);
#pragma unroll
        for (int ks = 0; ks < 2; ++ks) {
            lds_t* ka = L + pb + ML_BUFK + (32 * ks + 8 * g + q4) * KST + (32 * wid + 4 * p4) * 2;
            const bf16x8 A0 = mk8(trrd(ka), trrd(ka + 4 * KST)), A1 = mk8(trrd(ka + 32), trrd(ka + 32 + 4 * KST));
            nacc[0] = MFMA16(A0, ones, nacc[0]); nacc[1] = MFMA16(A1, ones, nacc[1]);
            lds_t* va = L + pb + ML_BUFV + (32 * ks + 8 * g + q4) * KST + (4 * p4) * 2;
#pragma unroll
            for (int n = 0; n < 16; ++n) { const bf16x8 Bf = mk8(trrd(va + 32 * n), trrd(va + 32 * n + 4 * KST));
                acc[0][n] = MFMA16(A0, Bf, acc[0][n]); acc[1][n] = MFMA16(A1, Bf, acc[1][n]); }
        }
    }
#undef MA_LOAD
    bf16_t* slot = STA + (size_t)(scan * NSC + o) * 65536;
#pragma unroll
    for (int a = 0; a < 2; ++a)
#pragma unroll
        for (int n = 0; n < 16; ++n) { u32x2 w; w.x = pk2(acc[a][n][0], acc[a][n][1]); w.y = pk2(acc[a][n][2], acc[a][n][3]);
            *(u32x2*)(slot + (size_t)(16 * n + l15) * 256 + 32 * wid + 16 * a + 4 * g) = w; }
    if (l15 == 0) {
#pragma unroll
        for (int a = 0; a < 2; ++a) *(f32x4*)(NST + (size_t)(scan * NSC + o) * 256 + 32 * wid + 16 * a + 4 * g) = nacc[a]; }
}

DI void mlstm_passB(bf16_t* STA, float* NST, float* SCA) {
    const int gt = blockIdx.x * 512 + opaque_tid(), NGT = gridDim.x * 512;
    for (int idx = gt; idx < 8 * 8192 + 8 * 64; idx += NGT) {
        const bool isn = idx >= 8 * 8192; const int r = isn ? idx - 8 * 8192 : idx; const int scan = isn ? r >> 6 : r >> 13, off = isn ? (r & 63) * 4 : (r & 8191) * 8;
        float run[8], mrun = 0.f;
#pragma unroll
        for (int i = 0; i < 8; ++i) run[i] = 0.f;
        u32x4 nlv[8]; f32x4 nnv[8]; float nBs[8], nmls[8];
#define MB_LOAD(o0_) do { _Pragma("unroll") for (int k = 0; k < 8; ++k) { if (isn) nnv[k] = *(const f32x4*)(NST + (size_t)(scan * NSC + (o0_) + k) * 256 + off); else nlv[k] = *(const u32x4*)(STA + (size_t)(scan * NSC + (o0_) + k) * 65536 + off); \
            nBs[k] = SCA[scan * NSC + (o0_) + k]; nmls[k] = SCA[520 + scan * NSC + (o0_) + k]; } } while (0)
        MB_LOAD(0);
        for (int o0 = 0; o0 < 64; o0 += 8) {
            u32x4 lv[8]; f32x4 nv[8]; float Bs[8], mls[8];
#pragma unroll
            for (int k = 0; k < 8; ++k) { lv[k] = nlv[k]; nv[k] = nnv[k]; Bs[k] = nBs[k]; mls[k] = nmls[k]; }
            if (o0 < 56) MB_LOAD(o0 + 8);
#pragma unroll
            for (int k = 0; k < 8; ++k) { const int o = o0 + k; const float Bv = Bs[k], ml = mls[k];
                const float mn = fmaxf(Bv + mrun, ml), dec = __expf(Bv + mrun - mn), sc = __expf(ml - mn); mrun = mn;
                if (isn) {
#pragma unroll
                    for (int i = 0; i < 4; ++i) run[i] = dec * run[i] + sc * nv[k][i];
                    *(f32x4*)(NST + (size_t)(scan * NSC + o) * 256 + off) = (f32x4){run[0], run[1], run[2], run[3]};
                    if (off == 0) SCA[1040 + scan * NSC + o] = mn;
                } else {
                    run[0] = dec * run[0] + sc * bflo(lv[k].x); run[1] = dec * run[1] + sc * bfhi(lv[k].x); run[2] = dec * run[2] + sc * bflo(lv[k].y); run[3] = dec * run[3] + sc * bfhi(lv[k].y);
                    run[4] = dec * run[4] + sc * bflo(lv[k].z); run[5] = dec * run[5] + sc * bfhi(lv[k].z); run[6] = dec * run[6] + sc * bflo(lv[k].w); run[7] = dec * run[7] + sc * bfhi(lv[k].w);
                    u32x4 w; w.x = pk2(run[0], run[1]); w.y = pk2(run[2], run[3]); w.z = pk2(run[4], run[5]); w.w = pk2(run[6], run[7]);
                    *(u32x4*)(STA + (size_t)(scan * NSC + o) * 65536 + off) = w; } }
        }
#undef MB_LOAD
    }
}

constexpr int MC_PAIR = 2 * 64 * KST, MC_SCAL = 2 * MC_PAIR;
DI void mlstm_passC(int item, lds_t* L, const bf16_t* P, bf16_t* HF, bf16_t* HB, const bf16_t* QKc, const float* G, const bf16_t* STA, const float* NST, const float* SCA) {
    const int tid = opaque_tid(), wid = tid >> 6, lane = tid & 63, g = lane >> 4, q4 = (lane >> 2) & 3, p4 = lane & 3, l15 = lane & 15;
    const int qb = item & 1, it2 = item >> 1, j = it2 % NSC, hd = it2 / NSC, d = hd & 1, h = hd >> 1, scan = hd, o = sc_order(d, j), row0 = 256 * j;
    const float m_in = o > 0 ? SCA[1040 + scan * NSC + o - 1] : 0.f;
    lds_t* LS = L + (MC_SCAL - ML_F0);
    const int trow = 128 * qb + 16 * wid + l15;
    const int kb_lo = d ? 2 * qb : 0, kb_hi = d ? 3 : 2 * qb + 1;
    const bf16_t* sin = STA + (size_t)(scan * NSC + (o > 0 ? o - 1 : 0)) * 65536;
    u32x4 pk[4], pv[4];
#define MC_LOADKV(kb_) do { _Pragma("unroll") for (int it = 0; it < 4; ++it) { const int c = tid + 512 * it, r = c >> 5, c16 = c & 31; const size_t grow = (size_t)(row0 + 64 * (kb_) + r); \
        pk[it] = *(const u32x4*)(QKc + grow * 2048 + 1024 + 256 * h + 8 * c16); pv[it] = *(const u32x4*)(P + PG(PC_V) + grow * 1024 + 256 * h + 8 * c16); } } while (0)
#define MC_LOADC(ep_) do { _Pragma("unroll") for (int it = 0; it < 4; ++it) { const int c = tid + 512 * it, r = c >> 5, c16 = c & 31; \
        pk[it] = *(const u32x4*)(sin + (size_t)(128 * (ep_) + r) * 256 + 8 * c16); pv[it] = *(const u32x4*)(sin + (size_t)(128 * (ep_) + 64 + r) * 256 + 8 * c16); } } while (0)
#define MC_STOREK(pb_) do { _Pragma("unroll") for (int it = 0; it < 4; ++it) { const int c = tid + 512 * it, r = c >> 5, c16 = c & 31; *(LAS u32x4*)(L + (pb_) + ML_BUFK + r * KST + 16 * c16) = pk[it]; } } while (0)
#define MC_STOREV(pb_) do { _Pragma("unroll") for (int it = 0; it < 4; ++it) { const int c = tid + 512 * it, r = c >> 5, c16 = c & 31; *(LAS u32x4*)(L + (pb_) + ML_BUFV + r * KST + 16 * c16) = pv[it]; } } while (0)
    bf16x8 Qf[8];
    { const bf16_t* qp = QKc + (size_t)(row0 + trow) * 2048 + 256 * h + 8 * g;
#pragma unroll
      for (int ks = 0; ks < 8; ++ks) Qf[ks] = *(const bf16x8*)(qp + 32 * ks); }
    if (o > 0) MC_LOADC(0); else MC_LOADKV(kb_lo);
    __syncthreads();
    if (wid == 0) { float Bv, mv; mlstm_scalars<1>(G, row0, h, d, m_in, LS, Bv, mv); }
    LAS float* NIN = (LAS float*)(LS + ML_F3);
    if (tid >= 256) NIN[tid - 256] = o > 0 ? NST[(size_t)(scan * NSC + o - 1) * 256 + tid - 256] : 0.f;
    __syncthreads();
    LAS float* U = (LAS float*)(LS + ML_F0); LAS float* MM = (LAS float*)(LS + ML_F1); LAS float* BBv = (LAS float*)(LS + ML_F2);
    const float Mt = MM[trow], at = __expf(m_in - Mt);
    f32x4 acc[16];
#pragma unroll
    for (int n = 0; n < 16; ++n) acc[n] = (f32x4){0.f, 0.f, 0.f, 0.f};
    if (o > 0) {
#pragma unroll
        for (int ep = 0; ep < 2; ++ep) {
            const int pb = ep * MC_PAIR;
            MC_STOREK(pb); MC_STOREV(pb);
            __syncthreads();
            if (ep < 1) MC_LOADC(1); else MC_LOADKV(kb_lo);
#pragma unroll
            for (int hh = 0; hh < 2; ++hh)
#pragma unroll
                for (int nt = 0; nt < 4; ++nt)
#pragma unroll
                    for (int ks = 0; ks < 8; ++ks) { const bf16x8 Af = *(LAS bf16x8*)(L + pb + (hh ? ML_BUFV : ML_BUFK) + (16 * nt + l15) * KST + (32 * ks + 8 * g) * 2);
                        acc[8 * ep + 4 * hh + nt] = MFMA16(Af, Qf[ks], acc[8 * ep + 4 * hh + nt]); }
        }
#pragma unroll
        for (int n = 0; n < 16; ++n) acc[n] *= at;
    }
    float den = 0.f;
    const int wmin = 128 * qb + 16 * wid, wmax = wmin + 15;
    for (int kb = kb_lo; kb <= kb_hi; ++kb) {
        const int pb = ((kb - kb_lo) & 1) * MC_PAIR;
        MC_STOREK(pb); MC_STOREV(pb);
        __syncthreads();
        if (kb < kb_hi) MC_LOADKV(kb + 1);
#pragma unroll
        for (int ks2 = 0; ks2 < 2; ++ks2) {
            const int s0 = 64 * kb + 32 * ks2;
            const bool skip = d ? (s0 + 31 < wmin) : (s0 > wmax);
            if (!skip) {
                f32x4 wv[2];
#pragma unroll
                for (int tt = 0; tt < 2; ++tt) {
                    wv[tt] = (f32x4){0.f, 0.f, 0.f, 0.f};
                    const bool tskip = d ? (s0 + 16 * tt + 15 < wmin) : (s0 + 16 * tt > wmax);
                    if (!tskip) { f32x4 sa = (f32x4){0.f, 0.f, 0.f, 0.f};
#pragma unroll
                        for (int ks = 0; ks < 8; ++ks) { const bf16x8 Af = *(LAS bf16x8*)(L + pb + ML_BUFK + (32 * ks2 + 16 * tt + l15) * KST + (32 * ks + 8 * g) * 2); sa = MFMA16(Af, Qf[ks], sa); }
                        const int sr = s0 + 16 * tt + 4 * g; const f32x4 us = *(LAS f32x4*)(U + sr);
#pragma unroll
                        for (int jj = 0; jj < 4; ++jj) { const bool ok = d ? (sr + jj >= trow) : (sr + jj <= trow); const float w = ok ? sa[jj] * __expf(us[jj] - Mt) : 0.f; den += w; wv[tt][jj] = w; } } }
                const bf16x8 Pf = pack8(wv[0], wv[1]);
                lds_t* va = L + pb + ML_BUFV + (32 * ks2 + 4 * g + q4) * KST + (4 * p4) * 2;
#pragma unroll
                for (int n = 0; n < 16; ++n) { const bf16x8 Vf = mk8(trrd(va + 32 * n), trrd(va + 32 * n + 16 * KST)); acc[n] = MFMA16(Vf, Pf, acc[n]); }
            }
        }
    }
#undef MC_LOADKV
#undef MC_LOADC
#undef MC_STOREK
#undef MC_STOREV
    den += shx(den, 16); den += shx(den, 32);
    float qn = 0.f;
#pragma unroll
    for (int ks = 0; ks < 8; ++ks) { const f32x4 n0 = *(LAS f32x4*)(NIN + 32 * ks + 8 * g), n1 = *(LAS f32x4*)(NIN + 32 * ks + 8 * g + 4); const u32x4 qw = __builtin_bit_cast(u32x4, Qf[ks]);
        qn += bflo(qw.x) * n0[0] + bfhi(qw.x) * n0[1] + bflo(qw.y) * n0[2] + bfhi(qw.y) * n0[3] + bflo(qw.z) * n1[0] + bfhi(qw.z) * n1[1] + bflo(qw.w) * n1[2] + bfhi(qw.w) * n1[3]; }
    qn += shx(qn, 16); qn += shx(qn, 32);
    den += __expf(m_in - Mt) * qn;
    const float inv = 1.0f / fmaxf(fabsf(den), __expf(-(BBv[trow] + Mt)));
    bf16_t* hp = (d ? HB : HF) + (size_t)(row0 + trow) * 1024 + 256 * h + 4 * g;
#pragma unroll
    for (int n = 0; n < 16; ++n) { u32x2 w; w.x = pk2(acc[n][0] * inv, acc[n][1] * inv); w.y = pk2(acc[n][2] * inv, acc[n][3] * inv); *(u32x2*)(hp + 16 * n) = w; }
}

constexpr int HST = 272;
typedef float f32x2v __attribute__((ext_vector_type(2)));
DI f32x2v mkf2(float a, float b) { f32x2v r = {a, b}; return r; }
constexpr int HG_PT = 0, HG_DEC = 2048, HG_EM = 2560, HG_EL = 3072, HG_QT = 3584, HG_KT = HG_QT + 32 * HST, HG_VV = HG_KT + 32 * HST;
constexpr int HG_SZ = HG_VV + 32 * HST;
template <bool OUT> DI void hgrn_item(int pair, lds_t* L0, bf16_t* P, bf16_t* STB, float* GSUM, const float* lbs) {
    const int tid = opaque_tid(), half = tid >> 8, lt = tid & 255, wl = lt >> 6, lane = tid & 63, g = lane >> 4, q4 = (lane >> 2) & 3, p4 = lane & 3, l15 = lane & 15;
    const int item = 2 * pair + half;
    lds_t* L = L0 + half * HG_SZ;
    const int j = item % NSC, hd = item / NSC, d = hd & 1, hb = hd >> 1, scan = hd, o = sc_order(d, j), row0 = 256 * j;
    const int cp = lane, c0 = 2 * cp, part = wl;
    const size_t fcol = PG(d ? PC_FB : PC_FF) + 128 * hb;
    const size_t ocol = PG(d ? PC_OB : PC_OF) + 128 * hb;
    const float lb0 = lbs[128 * hb + c0], lb1 = lbs[128 * hb + c0 + 1], om0 = 1.0f - lb0, om1 = 1.0f - lb1;
    LAS float* PT = (LAS float*)(L + HG_PT); LAS float* DEC = (LAS float*)(L + HG_DEC); LAS float* EM = (LAS float*)(L + HG_EM); LAS float* EL = (LAS float*)(L + HG_EL);
    f32x4 Sacc[2][8];
#pragma unroll
    for (int es = 0; es < 2; ++es) {
        if (OUT && o > 0) { const bf16_t* sin = STB + (size_t)(scan * NSC + o - 1) * 16384 + (size_t)(16 * (2 * wl + es) + l15) * 128 + 4 * g;
#pragma unroll
            for (int ct = 0; ct < 8; ++ct) { const u32x2 w = *(const u32x2*)(sin + 16 * ct); Sacc[es][ct] = (f32x4){bflo(w.x), bfhi(w.x), bflo(w.y), bfhi(w.y)}; }
        } else {
#pragma unroll
            for (int ct = 0; ct < 8; ++ct) Sacc[es][ct] = (f32x4){0.f, 0.f, 0.f, 0.f};
        }
    }
    float gsum0 = 0.f, gsum1 = 0.f;
    unsigned rf[8], rq[8]; u32x4 rv[2];
    const int vr = lt >> 4, vc16 = lt & 15;
#define HG_ROW(ch, i) (row0 + (d ? 255 - (32 * (ch) + (i)) : 32 * (ch) + (i)))
#define HG_LOAD(ch) do { _Pragma("unroll") for (int ii = 0; ii < 8; ++ii) { const bf16_t* pr = P + (size_t)HG_ROW(ch, 8 * part + ii) * 1024; rf[ii] = *(const unsigned*)(pr + fcol + c0); if (OUT) rq[ii] = *(const unsigned*)(pr + PG(PC_QB) + 128 * hb + c0); } \
        _Pragma("unroll") for (int v2 = 0; v2 < 2; ++v2) rv[v2] = *(const u32x4*)(P + PG(PC_IB) + (size_t)HG_ROW(ch, vr + 16 * v2) * 1024 + 128 * hb + 8 * vc16); } while (0)
    HG_LOAD(0);
    for (int ch = 0; ch < 8; ++ch) {
        float kk0[8], kk1[8], cs0[8], cs1[8]; float run0 = 0.f, run1 = 0.f;
#pragma unroll
        for (int ii = 0; ii < 8; ++ii) {
            { const float e = __expf(-bflo(rf[ii])), f = lb0 + om0 * __builtin_amdgcn_rcpf(1.0f + e); run0 += __builtin_amdgcn_logf(f); cs0[ii] = run0; kk0[ii] = 1.0f - f; }
            { const float e = __expf(-bfhi(rf[ii])), f = lb1 + om1 * __builtin_amdgcn_rcpf(1.0f + e); run1 += __builtin_amdgcn_logf(f); cs1[ii] = run1; kk1[ii] = 1.0f - f; } }
        *(LAS f32x2v*)(PT + part * 128 + c0) = mkf2(run0, run1);
        __syncthreads();
        const f32x2v t0 = *(LAS f32x2v*)(PT + c0), t1 = *(LAS f32x2v*)(PT + 128 + c0), t2 = *(LAS f32x2v*)(PT + 256 + c0), t3 = *(LAS f32x2v*)(PT + 384 + c0);
        const float pre0 = part == 0 ? 0.f : part == 1 ? t0.x : part == 2 ? t0.x + t1.x : t0.x + t1.x + t2.x;
        const float pre1 = part == 0 ? 0.f : part == 1 ? t0.y : part == 2 ? t0.y + t1.y : t0.y + t1.y + t2.y;
        const float gm0 = t0.x + t1.x, gm1 = t0.y + t1.y, gL0 = gm0 + t2.x + t3.x, gL1 = gm1 + t2.y + t3.y;
#pragma unroll
        for (int ii = 0; ii < 8; ++ii) { const int i = 8 * part + ii;
            if (!OUT) {
                *(LAS unsigned*)(L + HG_KT + i * HST + 2 * c0) = pk2(kk0[ii] * __builtin_amdgcn_exp2f(gL0 - pre0 - cs0[ii]), kk1[ii] * __builtin_amdgcn_exp2f(gL1 - pre1 - cs1[ii])); }
            float a0 = 0.f, a1 = 0.f;
            if (OUT) { a0 = __builtin_amdgcn_exp2f(__builtin_amdgcn_fmed3f(pre0 + cs0[ii] - gm0, -86.5f, 86.5f)); a1 = __builtin_amdgcn_exp2f(__builtin_amdgcn_fmed3f(pre1 + cs1[ii] - gm1, -86.5f, 86.5f)); }
            if (OUT) { *(LAS unsigned*)(L + HG_QT + i * HST + 2 * c0) = pk2(bflo(rq[ii]) * a0, bfhi(rq[ii]) * a1);
                *(LAS unsigned*)(L + HG_KT + i * HST + 2 * c0) = pk2(kk0[ii] * __builtin_amdgcn_rcpf(a0), kk1[ii] * __builtin_amdgcn_rcpf(a1)); } }
        if (part == 0) { *(LAS f32x2v*)(DEC + c0) = mkf2(__builtin_amdgcn_exp2f(gL0), __builtin_amdgcn_exp2f(gL1)); *(LAS f32x2v*)(EM + c0) = mkf2(__builtin_amdgcn_exp2f(gm0), __builtin_amdgcn_exp2f(gm1));
            *(LAS f32x2v*)(EL + c0) = mkf2(__builtin_amdgcn_exp2f(gL0 - gm0), __builtin_amdgcn_exp2f(gL1 - gm1)); gsum0 += gL0; gsum1 += gL1; }
#pragma unroll
        for (int v2 = 0; v2 < 2; ++v2) *(LAS u32x4*)(L + HG_VV + (vr + 16 * v2) * HST + 16 * vc16) = rv[v2];
        __syncthreads();
        if (ch < 7) HG_LOAD(ch + 1);
        bf16x8 P0, P1;
        if (OUT) {
            f32x4 s00 = (f32x4){0.f, 0.f, 0.f, 0.f}, s01 = s00, s11 = s00;
#pragma unroll
            for (int ks = 0; ks < 4; ++ks) {
                const bf16x8 K0 = *(LAS bf16x8*)(L + HG_KT + l15 * HST + (32 * ks + 8 * g) * 2), K1 = *(LAS bf16x8*)(L + HG_KT + (16 + l15) * HST + (32 * ks + 8 * g) * 2);
                const bf16x8 Q0 = *(LAS bf16x8*)(L + HG_QT + l15 * HST + (32 * ks + 8 * g) * 2), Q1 = *(LAS bf16x8*)(L + HG_QT + (16 + l15) * HST + (32 * ks + 8 * g) * 2);
                s00 = MFMA16(K0, Q0, s00); s01 = MFMA16(K0, Q1, s01); s11 = MFMA16(K1, Q1, s11); }
#pragma unroll
            for (int jj = 0; jj < 4; ++jj) { const bool ok = (4 * g + jj) <= l15; if (!ok) { s00[jj] = 0.f; s11[jj] = 0.f; } }
            P0 = pack8(s00, (f32x4){0.f, 0.f, 0.f, 0.f}); P1 = pack8(s01, s11);
        }
#pragma unroll
        for (int es = 0; es < 2; ++es) {
            const int ecol = 16 * (2 * wl + es);
            if (OUT) {
                lds_t* va = L + HG_VV + (4 * g + q4) * HST + (ecol + 4 * p4) * 2;
                const bf16x8 Vf = mk8(trrd(va), trrd(va + 16 * HST));
                f32x4 o0 = MFMA16(Vf, P0, ((f32x4){0.f, 0.f, 0.f, 0.f})), o1 = MFMA16(Vf, P1, ((f32x4){0.f, 0.f, 0.f, 0.f}));
#pragma unroll
                for (int ks = 0; ks < 4; ++ks) { const f32x4 em0 = *(LAS f32x4*)(EM + 32 * ks + 4 * g), em1 = *(LAS f32x4*)(EM + 32 * ks + 16 + 4 * g);
                    const bf16x8 Sf = pack8(Sacc[es][2 * ks] * em0, Sacc[es][2 * ks + 1] * em1);
                    lds_t* qa = L + HG_QT + l15 * HST + (32 * ks + 4 * g) * 2;
                    const bf16x8 B0 = mk8(*(LAS s16x4*)qa, *(LAS s16x4*)(qa + 32)), B1 = mk8(*(LAS s16x4*)(qa + 16 * HST), *(LAS s16x4*)(qa + 16 * HST + 32));
                    o0 = MFMA16(Sf, B0, o0); o1 = MFMA16(Sf, B1, o1); }
                { u32x2 w; w.x = pk2(o0[0], o0[1]); w.y = pk2(o0[2], o0[3]); *(u32x2*)(P + (size_t)HG_ROW(ch, l15) * 1024 + ocol + ecol + 4 * g) = w;
                  w.x = pk2(o1[0], o1[1]); w.y = pk2(o1[2], o1[3]); *(u32x2*)(P + (size_t)HG_ROW(ch, 16 + l15) * 1024 + ocol + ecol + 4 * g) = w; }
            }
            if (!OUT || ch < 7) {
                lds_t* vb = L + HG_VV + (8 * g + q4) * HST + (ecol + 4 * p4) * 2;
                const bf16x8 Vb = mk8(trrd(vb), trrd(vb + 4 * HST));
                lds_t* kb = L + HG_KT + (8 * g + q4) * HST + (4 * p4) * 2;
#pragma unroll
                for (int ct = 0; ct < 8; ++ct) { const f32x4 dc = *(LAS f32x4*)(DEC + 16 * ct + 4 * g), el = *(LAS f32x4*)(EL + 16 * ct + 4 * g);
                    const bf16x8 Ka = mk8(trrd(kb + 32 * ct), trrd(kb + 32 * ct + 4 * HST));
                    if (OUT) { const f32x4 up = MFMA16(Ka, Vb, ((f32x4){0.f, 0.f, 0.f, 0.f})); Sacc[es][ct] = Sacc[es][ct] * dc + up * el; }
                    else Sacc[es][ct] = MFMA16(Ka, Vb, Sacc[es][ct] * dc); }
            }
        }
        __syncthreads();
    }
    if (!OUT) {
#pragma unroll
        for (int es = 0; es < 2; ++es) { bf16_t* so = STB + (size_t)(scan * NSC + o) * 16384 + (size_t)(16 * (2 * wl + es) + l15) * 128 + 4 * g;
#pragma unroll
            for (int ct = 0; ct < 8; ++ct) { u32x2 w; w.x = pk2(Sacc[es][ct][0], Sacc[es][ct][1]); w.y = pk2(Sacc[es][ct][2], Sacc[es][ct][3]); *(u32x2*)(so + 16 * ct) = w; } }
        if (part == 0) *(f32x2v*)(GSUM + (size_t)(scan * NSC + o) * 128 + c0) = mkf2(gsum0, gsum1);
    }
#undef HG_ROW
#undef HG_LOAD
}

DI void hgrn_passB(bf16_t* STB, const float* GSUM) {
    const int gt = (gridDim.x - 1 - blockIdx.x) * 512 + opaque_tid(), NGT = gridDim.x * 512;
    for (int idx = gt; idx < 16 * 2048; idx += NGT) {
        const int scan = idx >> 11, off = (idx & 2047) * 8, c0 = off & 127;
        float run[8];
#pragma unroll
        for (int i = 0; i < 8; ++i) run[i] = 0.f;
        u32x4 nlv[8]; f32x4 ng0[8], ng1[8];
#define HB_LOAD(o0_) do { _Pragma("unroll") for (int k = 0; k < 8; ++k) { nlv[k] = *(const u32x4*)(STB + (size_t)(scan * NSC + (o0_) + k) * 16384 + off); \
            ng0[k] = *(const f32x4*)(GSUM + (size_t)(scan * NSC + (o0_) + k) * 128 + c0); ng1[k] = *(const f32x4*)(GSUM + (size_t)(scan * NSC + (o0_) + k) * 128 + c0 + 4); } } while (0)
        HB_LOAD(0);
        for (int o0 = 0; o0 < 64; o0 += 8) {
            u32x4 lv[8]; f32x4 g0[8], g1[8];
#pragma unroll
            for (int k = 0; k < 8; ++k) { lv[k] = nlv[k]; g0[k] = ng0[k]; g1[k] = ng1[k]; }
            if (o0 < 56) HB_LOAD(o0 + 8);
#pragma unroll
            for (int k = 0; k < 8; ++k) {
                run[0] = __builtin_amdgcn_exp2f(g0[k][0]) * run[0] + bflo(lv[k].x); run[1] = __builtin_amdgcn_exp2f(g0[k][1]) * run[1] + bfhi(lv[k].x); run[2] = __builtin_amdgcn_exp2f(g0[k][2]) * run[2] + bflo(lv[k].y); run[3] = __builtin_amdgcn_exp2f(g0[k][3]) * run[3] + bfhi(lv[k].y);
                run[4] = __builtin_amdgcn_exp2f(g1[k][0]) * run[4] + bflo(lv[k].z); run[5] = __builtin_amdgcn_exp2f(g1[k][1]) * run[5] + bfhi(lv[k].z); run[6] = __builtin_amdgcn_exp2f(g1[k][2]) * run[6] + bflo(lv[k].w); run[7] = __builtin_amdgcn_exp2f(g1[k][3]) * run[7] + bfhi(lv[k].w);
                u32x4 w; w.x = pk2(run[0], run[1]); w.y = pk2(run[2], run[3]); w.z = pk2(run[4], run[5]); w.w = pk2(run[6], run[7]);
                *(u32x4*)(STB + (size_t)(scan * NSC + o0 + k) * 16384 + off) = w; }
        }
    }
}

constexpr size_t OFF_LBS = WS_END;
constexpr size_t OFF_BAR = OFF_LBS + 4 * 1024 * 4;
constexpr size_t WS_TOTAL = OFF_BAR + 32768;


#define XB_TMO      128
#define XB_XCNT(j)  (256  + 64 * (j))
#define XB_XSUB(j)  (1280 + 64 * (j))
#define XB_XGEN(j)  (2304 + 64 * (j))
#define XB_TOP      3328
#define XB_TOPGEN   3392
#define XCD_BAR_WORDS 3456
#define XB_SPIN_CAP (1u << 22)
DI unsigned xb_ld(unsigned* p)              { return __hip_atomic_load(p, __ATOMIC_RELAXED, __HIP_MEMORY_SCOPE_AGENT); }
DI unsigned xb_add(unsigned* p, unsigned v) { return __hip_atomic_fetch_add(p, v, __ATOMIC_RELAXED, __HIP_MEMORY_SCOPE_AGENT); }
DI unsigned xb_xcc_id() { return (unsigned)__builtin_amdgcn_s_getreg((3 << 11) | 20) & 0xFu; }
#define XB_SPIN(cond, bar) do { unsigned _sp = 0; while (cond) { __builtin_amdgcn_s_sleep(1); \
    if ((++_sp & 255u) == 0u) { if (xb_ld(&(bar)[XB_TMO])) break; if (_sp > XB_SPIN_CAP) { atomicAdd(&(bar)[XB_TMO], 1u); break; } } } } while (0)
struct XcdBarrier { unsigned* bar; unsigned x; volatile LAS unsigned* st; };
DI XcdBarrier xcd_barrier_post(unsigned* bar, volatile LAS unsigned* st) {
    XcdBarrier b; b.bar = bar; b.x = xb_xcc_id(); b.st = st;
    if (threadIdx.x == 0) (void)xb_add(&bar[XB_XCNT(b.x)], 1u);
    return b;
}
DI void xcd_barrier_complete(unsigned* bar, unsigned x, unsigned& nloc, unsigned& nx) {
    const unsigned G = gridDim.x * gridDim.y * gridDim.z;
    unsigned sum, cnt, mine, sp = 0u;
    for (;;) {
        sum = 0u; cnt = 0u; mine = 0u;
#pragma unroll
        for (unsigned j = 0; j < 16; ++j) { const unsigned c = xb_ld(&bar[XB_XCNT(j)]); sum += c; cnt += (c > 0u) ? 1u : 0u; mine = (j == x) ? c : mine; }
        if (sum == G) break;
        __builtin_amdgcn_s_sleep(1);
        if ((++sp & 255u) == 0u) { if (xb_ld(&bar[XB_TMO])) break; if (sp > XB_SPIN_CAP) { atomicAdd(&bar[XB_TMO], 1u); break; } }
    }
    nloc = mine > 0u ? mine : 1u; nx = cnt > 0u ? cnt : 1u;
}
DI void xcd_barrier(const XcdBarrier& b) {
    asm volatile("s_waitcnt vmcnt(0) lgkmcnt(0)" ::: "memory");
    __syncthreads();
    if (threadIdx.x == 0) {
        unsigned* bar = b.bar;
        __builtin_amdgcn_s_waitcnt(0);
        unsigned nloc = b.st[0], nx = b.st[1];
        if (nloc == 0u) { xcd_barrier_complete(bar, b.x, nloc, nx); b.st[0] = nloc; b.st[1] = nx; }
        const unsigned old = xb_add(&bar[XB_XSUB(b.x)], 1u);
        const unsigned gen = old / nloc;
        if (old + 1u == (gen + 1u) * nloc) {
            __builtin_amdgcn_fence(__ATOMIC_RELEASE, "agent");
            asm volatile("s_waitcnt vmcnt(0)" ::: "memory");
            const unsigned og = xb_add(&bar[XB_TOP], 1u);
            const unsigned tg = og / nx;
            if (og + 1u == (tg + 1u) * nx) xb_add(&bar[XB_TOPGEN], 1u);
            else XB_SPIN(xb_ld(&bar[XB_TOPGEN]) == tg, bar);
            __builtin_amdgcn_fence(__ATOMIC_ACQUIRE, "agent");
            xb_add(&bar[XB_XGEN(b.x)], 1u);
            asm volatile("s_waitcnt vmcnt(0)" ::: "memory");
        } else {
            XB_SPIN(xb_ld(&bar[XB_XGEN(b.x)]) == gen, bar);
            __builtin_amdgcn_fence(__ATOMIC_ACQUIRE, "agent");
            asm volatile("s_waitcnt vmcnt(0)" ::: "memory");
        }
    }
    __syncthreads();
}
DI kparams_t ldp() { kparams_t k = (kparams_t)__builtin_amdgcn_kernarg_segment_ptr(); asm volatile("" : "+s"(k)); return k; }
#define WSP(type, off) ((type*)(q->ws + (off)))
#ifndef REP_H
#define REP_H 1
#endif
#ifndef REP_M
#define REP_M 1
#endif
#ifndef REP_G
#define REP_G 1
#endif
#ifndef REP_T
#define REP_T 1
#endif
#ifndef REP_B
#define REP_B 1
#endif
#ifndef REP_X
#define REP_X 1
#endif
#ifndef DUMP
#define DUMP 0
#endif

__global__ void __launch_bounds__(512, 2) fwd_megakernel(Params p_unused) {
    extern __shared__ __attribute__((aligned(16))) unsigned char lds_raw[];
    lds_t* L = (lds_t*)lds_raw;
    cg::grid_group grid = cg::this_grid();
    volatile LAS unsigned* bst = (volatile LAS unsigned*)(L + LDS_BYTES - 16);
    if (threadIdx.x < 4) bst[threadIdx.x] = 0u;
    __syncthreads();
    grid.sync();
    const XcdBarrier xbar = xcd_barrier_post((unsigned*)(ldp()->ws + OFF_BAR), bst);
#define GSYNC() for (int rb_ = 0; rb_ < REP_B; ++rb_) xcd_barrier(xbar)
    volatile LAS int* wqw = (volatile LAS int*)(L + LDS_BYTES - 32);
#define WQ_BEGIN(ctr_, n_) { unsigned* wqc_ = (ctr_); int nxt_ = 0; if (threadIdx.x == 0) nxt_ = (int)__hip_atomic_fetch_add(wqc_, 1u, __ATOMIC_RELAXED, __HIP_MEMORY_SCOPE_AGENT); \
        for (;;) { __syncthreads(); if (threadIdx.x == 0) *wqw = nxt_; __syncthreads(); const int u = __builtin_amdgcn_readfirstlane(*wqw); if (u >= (n_)) break; \
            if (threadIdx.x == 0) nxt_ = (int)__hip_atomic_fetch_add(wqc_, 1u, __ATOMIC_RELAXED, __HIP_MEMORY_SCOPE_AGENT);
#define WQ_END() } }

    { kparams_t q = ldp(); float* LBS = WSP(float, OFF_LBS);
      for (int c = blockIdx.x * 512 + threadIdx.x; c < 1024; c += gridDim.x * 512) {
        const float a0 = q->lb_logits[c], a1 = q->lb_logits[1024 + c], a2 = q->lb_logits[2048 + c], a3 = q->lb_logits[3072 + c];
        const float mx = fmaxf(fmaxf(a0, a1), fmaxf(a2, a3)); const float e0 = __expf(a0 - mx), e1 = __expf(a1 - mx), e2 = __expf(a2 - mx), e3 = __expf(a3 - mx); const float inv = 1.0f / (e0 + e1 + e2 + e3);
        LBS[c] = 0.f; LBS[1024 + c] = e1 * inv; LBS[2048 + c] = (e1 + e2) * inv; LBS[3072 + c] = (e1 + e2 + e3) * inv; }
      phase_ada(q, L, WSP(float, OFF_MOD)); }
    GSYNC();

    for (int l = 0; l < DEPTH; ++l) {
        for (int b = 0; b < NB; ++b) {
            { kparams_t q = ldp();
              for (int rep = 0; rep < REP_T; ++rep) if (b == 0) phase_wconv(q, L, l, WSP(bf16_t, OFF_BTIN), WSP(bf16_t, OFF_BTA), WSP(bf16_t, OFF_BTB), WSP(bf16_t, OFF_BTO), WSP(float, OFF_BIAS));
              const float* xl_src = (l == 0 ? q->x : q->out) + (size_t)b * SEQ * DM; const float* xc_src = (l == 0 ? q->ctx : WSP(float, OFF_XC)) + (size_t)b * CTX * DM;
              for (int rep = 0; rep < REP_X; ++rep) phase_norm(q, l, b, xl_src, xc_src, WSP(float, OFF_MOD), WSP(bf16_t, OFF_HA)); }
            GSYNC();
            { kparams_t q = ldp(); pg8::Gemm g{WSP(bf16_t, OFF_HA), WSP(bf16_t, OFF_BTIN), MB, NPAD, DM, DM}; pg8::StaticOrder S; S.init(MB, NPAD, gridDim.x, blockIdx.x);
              EpiIn E{WSP(bf16_t, OFF_P), WSP(float, OFF_G), WSP(float, OFF_BIAS)};
              for (int rep = 0; rep < REP_G; ++rep) pg8::gemm_phase<EpiIn, pg8::StaticOrder>(L, g, S, E); }
            GSYNC();
            { kparams_t q = ldp(); for (int rep = 0; rep < REP_T; ++rep) phase_conv(q, l, WSP(bf16_t, OFF_P), WSP(bf16_t, OFF_QKC)); }
            GSYNC();
            { kparams_t q = ldp();
              unsigned* wqc4 = (unsigned*)(q->ws + OFF_BAR) + 4096 + 64 * (4 * l + 2 * b);
              int nx4 = 0; if (threadIdx.x == 0) nx4 = (int)__hip_atomic_fetch_add(wqc4, 1u, __ATOMIC_RELAXED, __HIP_MEMORY_SCOPE_AGENT);
#define WQ4_DRAW(u_) do { __syncthreads(); if (threadIdx.x == 0) *wqw = nx4; __syncthreads(); (u_) = __builtin_amdgcn_readfirstlane(*wqw); \
        if (threadIdx.x == 0 && (u_) < 16 * NSC) nx4 = (int)__hip_atomic_fetch_add(wqc4, 1u, __ATOMIC_RELAXED, __HIP_MEMORY_SCOPE_AGENT); } while (0)
              int u4; WQ4_DRAW(u4);
              while (u4 < 8 * NSC) { hgrn_item<false>(u4, L, WSP(bf16_t, OFF_P), WSP(bf16_t, OFF_STB), WSP(float, OFF_GSUM), WSP(float, OFF_LBS) + l * 1024); WQ4_DRAW(u4); }
              while (u4 < 16 * NSC) { mlstm_passA(u4 - 8 * NSC, L, WSP(bf16_t, OFF_P), WSP(bf16_t, OFF_QKC), WSP(float, OFF_G), WSP(bf16_t, OFF_STA), WSP(float, OFF_NST), WSP(float, OFF_SCA)); WQ4_DRAW(u4); }
#undef WQ4_DRAW
            }
            GSYNC();
            { kparams_t q = ldp(); mlstm_passB(WSP(bf16_t, OFF_STA), WSP(float, OFF_NST), WSP(float, OFF_SCA)); }
            { kparams_t q = ldp(); hgrn_passB(WSP(bf16_t, OFF_STB), WSP(float, OFF_GSUM)); }
            GSYNC();
            { kparams_t q = ldp();
              unsigned* wqc6 = (unsigned*)(q->ws + OFF_BAR) + 4096 + 64 * (4 * l + 2 * b + 1);
              int nx6 = 0; if (threadIdx.x == 0) nx6 = (int)__hip_atomic_fetch_add(wqc6, 1u, __ATOMIC_RELAXED, __HIP_MEMORY_SCOPE_AGENT);
#define WQ6_DRAW(u_) do { __syncthreads(); if (threadIdx.x == 0) *wqw = nx6; __syncthreads(); (u_) = __builtin_amdgcn_readfirstlane(*wqw); \
        if (threadIdx.x == 0 && (u_) < 24 * NSC) nx6 = (int)__hip_atomic_fetch_add(wqc6, 1u, __ATOMIC_RELAXED, __HIP_MEMORY_SCOPE_AGENT); } while (0)
              int u6; WQ6_DRAW(u6);
              while (u6 < 8 * NSC) { hgrn_item<true>(u6, L, WSP(bf16_t, OFF_P), WSP(bf16_t, OFF_STB), WSP(float, OFF_GSUM), WSP(float, OFF_LBS) + l * 1024); WQ6_DRAW(u6); }
              while (u6 < 24 * NSC) {
                  const int v = u6 - 8 * NSC, it2 = v < 8 * NSC ? v : v - 8 * NSC, dd = (it2 / NSC) & 1, qb = (v < 8 * NSC) ? 1 - dd : dd;
                  mlstm_passC(2 * it2 + qb, L, WSP(bf16_t, OFF_P), WSP(bf16_t, OFF_HA), WSP(bf16_t, OFF_HB2), WSP(bf16_t, OFF_QKC), WSP(float, OFF_G), WSP(bf16_t, OFF_STA), WSP(float, OFF_NST), WSP(float, OFF_SCA));
                  WQ6_DRAW(u6); }
#undef WQ6_DRAW
            }
            GSYNC();
            { kparams_t q = ldp(); phase_post(q, l, WSP(bf16_t, OFF_P), WSP(bf16_t, OFF_HA), WSP(bf16_t, OFF_HB2)); }
            GSYNC();
            { kparams_t q = ldp(); pg8::Gemm g{WSP(bf16_t, OFF_P) + PG(PC_O) + (size_t)CTX * DM, WSP(bf16_t, OFF_BTA), SEQ, DM, DM, DM}; pg8::StaticOrder S; S.init(SEQ, DM, gridDim.x, blockIdx.x); EpiMerge<0> E{WSP(bf16_t, OFF_P), WSP(bf16_t, OFF_HA)};
              for (int rep = 0; rep < REP_X; ++rep) pg8::gemm_phase<EpiMerge<0>, pg8::StaticOrder>(L, g, S, E); }
            { kparams_t q = ldp(); pg8::Gemm g{WSP(bf16_t, OFF_P) + PG(PC_ZB) + (size_t)CTX * DM, WSP(bf16_t, OFF_BTB), SEQ, DM, DM, DM}; pg8::StaticOrder S; S.init(SEQ, DM, gridDim.x, blockIdx.x); EpiMerge<1> E{WSP(bf16_t, OFF_P), WSP(bf16_t, OFF_HA)};
              pg8::gemm_phase<EpiMerge<1>, pg8::StaticOrder>(L, g, S, E); }
            if (l < DEPTH - 1) { kparams_t q = ldp(); const bf16_t* Pp = WSP(bf16_t, OFF_P);
              ctx_patch<0>(L, Pp + PG(PC_O), WSP(bf16_t, OFF_BTA), Pp + PG(PC_ZB), WSP(bf16_t, OFF_BTB), Pp + PG(PC_MA), Pp + PG(PC_MB), WSP(bf16_t, OFF_HA), nullptr, nullptr, nullptr); }
            GSYNC();
            { kparams_t q = ldp(); pg8::Gemm g{WSP(bf16_t, OFF_HA) + (size_t)CTX * DM, WSP(bf16_t, OFF_BTO), SEQ, DM, DM, DM}; pg8::StaticOrder S; S.init(SEQ, DM, gridDim.x, blockIdx.x);
              const float* xl_src = (l == 0 ? q->x : q->out) + (size_t)b * SEQ * DM; float* xl_dst = q->out + (size_t)b * SEQ * DM;
              EpiOut E{xl_src, xl_dst, WSP(float, OFF_MOD) + (l * 3 + b) * 3072 + 2048};
              pg8::gemm_phase<EpiOut, pg8::StaticOrder>(L, g, S, E); }
            if (l < DEPTH - 1) { kparams_t q = ldp();
              const float* xc_src = (l == 0 ? q->ctx : WSP(float, OFF_XC)) + (size_t)b * CTX * DM; float* xc_dst = WSP(float, OFF_XC) + (size_t)b * CTX * DM;
              ctx_patch<1>(L, WSP(bf16_t, OFF_HA), WSP(bf16_t, OFF_BTO), nullptr, nullptr, nullptr, nullptr, nullptr, xc_src, xc_dst, WSP(float, OFF_MOD) + (l * 3 + 2) * 3072 + 2048); }
            GSYNC();
        }
    }
    { kparams_t q = ldp(); phase_final(q, q->out); }
}

extern "C" void kernel_launch(void* const* d_in, const int* in_sizes, int n_in, void* d_out, int out_size, void* d_ws, size_t ws_size, hipStream_t stream) {
    static int grid = 0;
    if (grid == 0) {
        int dev = 0, cus = 0, per_cu = 0;
        if (n_in != 18 || ws_size < WS_TOTAL) { fprintf(stderr, "kernel_launch: unexpected n_in %d / ws_size %zu (need %zu)\n", n_in, ws_size, (size_t)WS_TOTAL); }
        hipGetDevice(&dev); hipDeviceGetAttribute(&cus, hipDeviceAttributeMultiprocessorCount, dev);
        hipFuncSetAttribute((const void*)fwd_megakernel, hipFuncAttributeMaxDynamicSharedMemorySize, LDS_BYTES);
        hipOccupancyMaxActiveBlocksPerMultiprocessor(&per_cu, (const void*)fwd_megakernel, 512, LDS_BYTES);
        if (per_cu < 1) { fprintf(stderr, "kernel_launch: occupancy query gave %d\n", per_cu); per_cu = 1; }
        (void)hipGetLastError();
        grid = cus * per_cu;
    }
    if (ws_size < WS_TOTAL) return;
    Params p; memset(&p, 0, sizeof(p));
    const float** pf = (const float**)&p;
    for (int i = 0; i < 18; ++i) pf[i] = (const float*)d_in[i];
    p.out = (float*)d_out; p.ws = (unsigned char*)d_ws;
    (void)hipMemsetAsync((unsigned char*)d_ws + OFF_BAR, 0, 32768, stream);
    void* args[] = {&p};
    hipError_t e = hipLaunchCooperativeKernel((const void*)fwd_megakernel, dim3(grid), dim3(512), args, LDS_BYTES, stream);
    if (e != hipSuccess) fprintf(stderr, "cooperative launch failed: %s (grid %d)\n", hipGetErrorString(e), grid);
}
```

```cpp
#include <hip/hip_runtime.h>
#include <hip/hip_cooperative_groups.h>
#include <cstdio>
#include <cstring>
namespace cg = cooperative_groups;

#define LAS __attribute__((address_space(3)))
#define DI __device__ __forceinline__
typedef unsigned short bf16_t;
typedef short bf16x8 __attribute__((ext_vector_type(8)));
typedef short s16x4 __attribute__((ext_vector_type(4)));
typedef float f32x4 __attribute__((ext_vector_type(4)));
typedef unsigned u32x4 __attribute__((ext_vector_type(4)));
typedef unsigned u32x2 __attribute__((ext_vector_type(2)));
typedef LAS unsigned char lds_t;
__device__ __forceinline__ int opaque_tid() { int t = threadIdx.x; asm volatile("" : "+v"(t)); return t; }

namespace pg8 {
constexpr int BM = 256, BK = 64, HALF = 128, HTB = HALF * BK * 2, STAGE_BYTES = 8 * HTB, NXCD = 8, WGM = 8;
__host__ __device__ __forceinline__ int lds_byte(int r, int c) { const int st = (r >> 4) * 2 + (c >> 5), rr = r & 15, cc = c & 31, ob = rr * 64 + cc * 2; return st * 1024 + (ob ^ (((ob >> 9) & 1) << 5)); }
__host__ __device__ __forceinline__ void stage_rc(int b, int& R, int& C) { const int st = b / 1024, sb = b % 1024, swz = sb ^ (((sb >> 9) & 1) << 5); R = (st >> 1) * 16 + swz / 64; C = (st & 1) * 32 + (swz % 64) / 2; }
__host__ __device__ __forceinline__ int perm32(int rho) { const int n = rho >> 4, i = rho & 15; return 8 * (i >> 2) + 4 * n + (i & 3); }
struct Unit { int pm, pn; };
struct Gemm { const bf16_t* A; const bf16_t* Bt; int M, N, K, lda; };
struct StaticOrder {
    int nM, nN, nwg, G, c;
    __host__ __device__ void init(int M, int N, int G_, int c_) { nM = M / BM; nN = N / BM; nwg = nM * nN; G = G_; c = c_; }
    __host__ __device__ bool next(int i, Unit& u) const {
        const long L = (long)i * G + c; if (L >= nwg) return false;
        int wgid = (int)L; { const int q = nwg / NXCD, r = nwg % NXCD, xcd = wgid % NXCD, off = wgid / NXCD; wgid = (xcd < r ? xcd * (q + 1) : r * (q + 1) + (xcd - r) * q) + off; }
        const int nig = WGM * nN, gid = wgid / nig, fm = gid * WGM, gsz = (nM - fm) < WGM ? (nM - fm) : WGM;
        u.pm = fm + ((wgid % nig) % gsz); u.pn = (wgid % nig) / gsz; return true;
    }
    __device__ __forceinline__ void a_ready(const Unit&) const {}
    __device__ __forceinline__ void done(const Unit&) const {}
};
typedef float f32x2_ __attribute__((ext_vector_type(2)));
typedef __bf16 bf16x2_ __attribute__((ext_vector_type(2)));
__device__ __forceinline__ unsigned cvt_pk_bf16(float lo, float hi) { const f32x2_ v = {lo, hi}; const bf16x2_ r = __builtin_convertvector(v, bf16x2_); return __builtin_bit_cast(unsigned, r); }

template <class Epi, class Sched>
__device__ __forceinline__ void gemm_phase(lds_t* lds, const Gemm g, const Sched& S, const Epi& E) {
    const int tid = opaque_tid(), wid = __builtin_amdgcn_readfirstlane(tid >> 6), lane = tid & 63, wr = wid >> 2, wc = wid & 3, fr = lane & 15, fq = lane >> 4;
    const int K = g.K, nt = K / BK, lda = g.lda;
    unsigned voffA[2], voffB[2];
#pragma unroll
    for (int i = 0; i < 2; ++i) { int R, C; stage_rc(tid * 16 + i * 8192, R, C); const int Rb = Epi::PERM ? ((R & ~31) + perm32(R & 31)) : R;
        voffA[i] = (unsigned)(R * lda + C) * 2u; voffB[i] = (unsigned)(Rb * K + C) * 2u; }
    const size_t kstep = (size_t)(BK * 2);
    const size_t hstepA = (size_t)HALF * lda * 2, hstepB = (size_t)HALF * K * 2;
    const size_t tstepA = 2 * hstepA, tstepB = 2 * hstepB;
    const unsigned ldsw = (unsigned)wid * 1024u;
    const int aoff = lds_byte(wr * 64 + fr, fq * 8), boff = lds_byte(wc * 32 + fr, fq * 8);
#define PG8_SA(b, h) (((b) * 2 + (h)) * HTB)
#define PG8_SB(b, h) ((4 + (b) * 2 + (h)) * HTB)
#define PG8_STAGE(bufoff, gbase, voff) do { _Pragma("unroll") for (int _i = 0; _i < 2; ++_i) \
        __builtin_amdgcn_global_load_lds((const unsigned*)((const char*)(gbase) + (voff)[_i]), (LAS unsigned*)(lds + (bufoff) + ldsw + _i * 8192), 16, 0, 0); } while (0)
#define PG8_LDA(dst, b, h) do { _Pragma("unroll") for (int m = 0; m < 4; ++m) _Pragma("unroll") for (int k = 0; k < 2; ++k) dst[m][k] = *(const LAS bf16x8*)(lds + PG8_SA(b, h) + aoff + m * 2048 + k * 1024); } while (0)
#define PG8_LDB(dst, b, h) do { _Pragma("unroll") for (int n = 0; n < 2; ++n) _Pragma("unroll") for (int k = 0; k < 2; ++k) dst[n][k] = *(const LAS bf16x8*)(lds + PG8_SB(b, h) + boff + n * 2048 + k * 1024); } while (0)
#define PG8_MMA(ai, bj, At, Bt) do { __builtin_amdgcn_s_setprio(1); _Pragma("unroll") for (int m = 0; m < 4; ++m) _Pragma("unroll") for (int n = 0; n < 2; ++n) _Pragma("unroll") for (int k = 0; k < 2; ++k) \
        acc[ai][bj][m][n] = __builtin_amdgcn_mfma_f32_16x16x32_bf16(Bt[n][k], At[m][k], acc[ai][bj][m][n], 0, 0, 0); __builtin_amdgcn_s_setprio(0); } while (0)
#define PG8_WAIT_V(n) asm volatile("s_waitcnt vmcnt(" #n ")" ::: "memory")
#define PG8_WAIT_L(n) asm volatile("s_waitcnt lgkmcnt(" #n ")" ::: "memory")
#define PG8_BAR __builtin_amdgcn_s_barrier()
#define PG8_SCHED __builtin_amdgcn_sched_barrier(0)
    Unit cur, nxt; int ui = 0;
    if (!S.next(0, cur)) return;
    f32x4 acc[2][2][4][2];
#pragma unroll
    for (int a = 0; a < 2; ++a)
#pragma unroll
        for (int b = 0; b < 2; ++b)
#pragma unroll
            for (int m = 0; m < 4; ++m)
#pragma unroll
                for (int n = 0; n < 2; ++n) acc[a][b][m][n] = (f32x4){0.f, 0.f, 0.f, 0.f};
    bf16x8 At[4][2], B0[2][2], B1[2][2];
    const char* cA = (const char*)g.A + (size_t)cur.pm * tstepA; const char* cB = (const char*)g.Bt + (size_t)cur.pn * tstepB;
    S.a_ready(cur);
    PG8_STAGE(PG8_SB(0, 0), cB, voffB); PG8_STAGE(PG8_SA(0, 0), cA, voffA); PG8_STAGE(PG8_SB(0, 1), cB + hstepB, voffB); PG8_STAGE(PG8_SA(0, 1), cA + hstepA, voffA);
    if (wr == 1) PG8_BAR;
    PG8_WAIT_V(4); PG8_BAR;
    PG8_STAGE(PG8_SB(1, 0), cB + kstep, voffB); PG8_STAGE(PG8_SA(1, 0), cA + kstep, voffA); PG8_STAGE(PG8_SB(1, 1), cB + hstepB + kstep, voffB);
    PG8_WAIT_V(6); PG8_BAR;
    for (;;) {
        const bool has_next = S.next(ui + 1, nxt);
        const char* nA = has_next ? (const char*)g.A + (size_t)nxt.pm * tstepA : cA; const char* nB = has_next ? (const char*)g.Bt + (size_t)nxt.pn * tstepB : cB;
        for (int t = 0; t < nt; t += 2) {
            const bool last = (t == nt - 2);
            const char* a1 = cA + (size_t)(t + 1) * kstep;
            const char* a2 = last ? nA : cA + (size_t)(t + 2) * kstep; const char* b2 = last ? nB : cB + (size_t)(t + 2) * kstep;
            const char* a3 = a2 + kstep; const char* b3 = b2 + kstep;
            if (last && has_next) S.a_ready(nxt);
            PG8_LDB(B0, 0, 0); PG8_SCHED; PG8_LDA(At, 0, 0); PG8_STAGE(PG8_SA(1, 1), a1 + hstepA, voffA);
            PG8_WAIT_L(8); PG8_BAR; PG8_WAIT_L(0); PG8_MMA(0, 0, At, B0); PG8_BAR; PG8_SCHED;
            PG8_LDB(B1, 0, 1); PG8_STAGE(PG8_SB(0, 0), b2, voffB);
            PG8_BAR; PG8_WAIT_L(0); PG8_MMA(0, 1, At, B1); PG8_BAR;
            PG8_LDA(At, 0, 1); PG8_STAGE(PG8_SA(0, 0), a2, voffA);
            PG8_BAR; PG8_WAIT_L(0); PG8_MMA(1, 0, At, B0); PG8_BAR; PG8_SCHED;
            PG8_STAGE(PG8_SB(0, 1), b2 + hstepB, voffB);
            PG8_WAIT_V(6); PG8_BAR; PG8_MMA(1, 1, At, B1); PG8_BAR;
            PG8_LDB(B0, 1, 0); PG8_SCHED; PG8_LDA(At, 1, 0); PG8_STAGE(PG8_SA(0, 1), a2 + hstepA, voffA);
            PG8_WAIT_L(8); PG8_BAR; PG8_WAIT_L(0); PG8_MMA(0, 0, At, B0); PG8_BAR; PG8_SCHED;
            PG8_LDB(B1, 1, 1); PG8_STAGE(PG8_SB(1, 0), b3, voffB);
            PG8_BAR; PG8_WAIT_L(0); PG8_MMA(0, 1, At, B1); PG8_BAR;
            PG8_LDA(At, 1, 1); PG8_STAGE(PG8_SA(1, 0), a3, voffA);
            PG8_BAR; PG8_WAIT_L(0); PG8_MMA(1, 0, At, B0); PG8_BAR; PG8_SCHED;
            PG8_STAGE(PG8_SB(1, 1), b3 + hstepB, voffB);
            PG8_WAIT_V(6); PG8_BAR; PG8_MMA(1, 1, At, B1); PG8_BAR;
        }
        bool keep = false;
        if constexpr (Epi::CHAIN) keep = E.run(acc, cur, wr, wc, fr, fq); else E(acc, cur, wr, wc, fr, fq);
        S.done(cur);
        if (!has_next) break;
        if (!keep) {
#pragma unroll
        for (int a = 0; a < 2; ++a)
#pragma unroll
            for (int b = 0; b < 2; ++b)
#pragma unroll
                for (int m = 0; m < 4; ++m)
#pragma unroll
                    for (int n = 0; n < 2; ++n) acc[a][b][m][n] = (f32x4){0.f, 0.f, 0.f, 0.f};
        }
        cur = nxt; cA = nA; cB = nB; ++ui;
    }
    PG8_WAIT_V(0);
    if (wr == 0) PG8_BAR;
    PG8_BAR;
#undef PG8_SA
#undef PG8_SB
#undef PG8_STAGE
#undef PG8_LDA
#undef PG8_LDB
#undef PG8_MMA
#undef PG8_WAIT_V
#undef PG8_WAIT_L
#undef PG8_BAR
#undef PG8_SCHED
}
}

constexpr int DM = 1024, NB = 2, SEQ = 16384, DEPTH = 4, CTX = 256, NIN_W = 12304;
constexpr int MB = CTX + SEQ;
constexpr int NSC = MB / 256;
constexpr int PW = 12288;
constexpr int NPAD = 12544;
constexpr int PC_QK = 0, PC_V = 2048, PC_O = 3072, PC_ZA = 4096, PC_QB = 5120, PC_IB = 6144, PC_FF = 7168, PC_FB = 8192, PC_ZB = 9216, PC_MA = 10240, PC_MB = 11264;
constexpr int PC_OF = 0, PC_OB = 1024;
constexpr float EPS = 1e-6f;
constexpr size_t GS = (size_t)(CTX + SEQ) * 1024;
#define PG(c) ((size_t)((c) >> 10) * GS)

constexpr size_t al256(size_t x) { return (x + 255) & ~(size_t)255; }
constexpr size_t OFF_P = 0;
constexpr size_t OFF_QKC = OFF_P + al256((size_t)MB * PW * 2);
constexpr size_t OFF_HA = OFF_QKC + al256((size_t)MB * 2048 * 2);
constexpr size_t OFF_G = OFF_HA + al256((size_t)MB * DM * 2);
constexpr size_t OFF_BTIN = OFF_G + al256((size_t)MB * 16 * 4);
constexpr size_t OFF_BTA = OFF_BTIN + al256((size_t)NPAD * DM * 2);
constexpr size_t OFF_BTB = OFF_BTA + al256((size_t)DM * DM * 2);
constexpr size_t OFF_BTO = OFF_BTB + al256((size_t)DM * DM * 2);
constexpr size_t OFF_BIAS = OFF_BTO + al256((size_t)DM * DM * 2);
constexpr size_t OFF_STA = OFF_BIAS + al256((size_t)NPAD * 4);
constexpr size_t OFF_NST = OFF_STA + al256((size_t)8 * NSC * 65536 * 2);
constexpr size_t OFF_SCA = OFF_NST + al256((size_t)8 * NSC * 256 * 4);
constexpr size_t OFF_STB = OFF_SCA + 8192;
constexpr size_t OFF_GSUM = OFF_STB + al256((size_t)16 * NSC * 16384 * 2);
constexpr size_t OFF_XC = OFF_GSUM + al256((size_t)16 * NSC * 128 * 4);
constexpr size_t OFF_MOD = OFF_XC + al256((size_t)NB * CTX * DM * 4);
constexpr size_t OFF_HB2 = OFF_MOD + al256((size_t)DEPTH * 3 * 3072 * 4);
constexpr size_t WS_END = OFF_HB2 + al256((size_t)MB * DM * 2);

constexpr int LDS_BYTES = 147456;

struct Params {
    const float *x, *c, *ctx, *c_ctx, *w_ada, *b_ada, *g_norm, *w_in, *b_in, *w_conv, *b_conv, *lb_logits, *g_head_a, *g_head_b, *w_a, *w_b, *w_out, *g_final;
    float* out; unsigned char* ws;
};

typedef const __attribute__((address_space(4))) Params* kparams_t;
DI float bf2f(unsigned short b) { return __uint_as_float(((unsigned)b) << 16); }
DI float bflo(unsigned w) { return __uint_as_float(w << 16); }
DI float bfhi(unsigned w) { return __uint_as_float(w & 0xffff0000u); }
DI unsigned pk2(float lo, float hi) { return pg8::cvt_pk_bf16(lo, hi); }
DI unsigned short f2bf(float f) { return (unsigned short)(pk2(f, 0.f) & 0xffffu); }
DI int lane_id_op() { int l = (int)__builtin_amdgcn_mbcnt_hi(~0u, __builtin_amdgcn_mbcnt_lo(~0u, 0u)); asm volatile("" : "+v"(l)); return l; }
DI float shx(float v, int o) { return __builtin_bit_cast(float, __builtin_amdgcn_ds_bpermute((lane_id_op() ^ o) << 2, __builtin_bit_cast(int, v))); }
DI float shup(float v, int o) { const int l = lane_id_op(); const int src = l >= o ? l - o : l; return __builtin_bit_cast(float, __builtin_amdgcn_ds_bpermute(src << 2, __builtin_bit_cast(int, v))); }
DI float rdlane63(float v) { return __builtin_bit_cast(float, __builtin_amdgcn_readlane(__builtin_bit_cast(int, v), 63)); }
DI float wave_sum(float v) {
#pragma unroll
    for (int o = 1; o < 64; o <<= 1) v += shx(v, o);
    return v;
}
DI float wave_max(float v) {
#pragma unroll
    for (int o = 1; o < 64; o <<= 1) v = fmaxf(v, shx(v, o));
    return v;
}
DI float sigmoidf_(float x) { return 1.0f / (1.0f + __expf(-x)); }
DI float siluf_(float x) { return x / (1.0f + __expf(-x)); }
DI float logsigmoidf_(float x) { return fminf(x, 0.f) - log1pf(__expf(-fabsf(x))); }
DI bf16x8 mk8(s16x4 a, s16x4 b) { bf16x8 r; r[0] = a[0]; r[1] = a[1]; r[2] = a[2]; r[3] = a[3]; r[4] = b[0]; r[5] = b[1]; r[6] = b[2]; r[7] = b[3]; return r; }
DI s16x4 trrd(lds_t* p) { return __builtin_amdgcn_ds_read_tr16_b64_v4i16((LAS s16x4*)p); }
DI bf16x8 pack8(f32x4 a, f32x4 b) { u32x4 w; w.x = pk2(a[0], a[1]); w.y = pk2(a[2], a[3]); w.z = pk2(b[0], b[1]); w.w = pk2(b[2], b[3]); return __builtin_bit_cast(bf16x8, w); }
#define MFMA16(a, b, c) __builtin_amdgcn_mfma_f32_16x16x32_bf16(a, b, c, 0, 0, 0)

struct EpiIn {
    static constexpr bool PERM = true, AFTER_DRAIN = false, CHAIN = false;
    bf16_t* P; float* G; const float* bias;
    DI void operator()(const f32x4 (&acc)[2][2][4][2], const pg8::Unit& u, int wr, int wc, int fr, int fq) const {
        const int row0 = u.pm * 256 + wr * 64 + fr, col0 = u.pn * 256 + wc * 32 + 8 * fq;
        f32x4 bv[2][2];
#pragma unroll
        for (int bj = 0; bj < 2; ++bj)
#pragma unroll
            for (int n = 0; n < 2; ++n) bv[bj][n] = *(const f32x4*)(bias + col0 + bj * 128 + 4 * n);
        if (u.pn < 48) {
#pragma unroll
            for (int ai = 0; ai < 2; ++ai)
#pragma unroll
                for (int m = 0; m < 4; ++m) { bf16_t* rowp = P + (size_t)(u.pn >> 2) * GS + (size_t)(row0 + ai * 128 + m * 16) * 1024 + (col0 & 1023);
#pragma unroll
                    for (int bj = 0; bj < 2; ++bj) { const f32x4 v0 = acc[ai][bj][m][0] + bv[bj][0], v1 = acc[ai][bj][m][1] + bv[bj][1];
                        u32x4 w; w.x = pk2(v0[0], v0[1]); w.y = pk2(v0[2], v0[3]); w.z = pk2(v1[0], v1[1]); w.w = pk2(v1[2], v1[3]);
                        *(u32x4*)(rowp + bj * 128) = w; } }
        } else if (wc == 0 && fq < 2) {
#pragma unroll
            for (int ai = 0; ai < 2; ++ai)
#pragma unroll
                for (int m = 0; m < 4; ++m) { float* gp = G + (size_t)(row0 + ai * 128 + m * 16) * 16 + 8 * fq;
                    *(f32x4*)gp = acc[ai][0][m][0] + bv[0][0]; *(f32x4*)(gp + 4) = acc[ai][0][m][1] + bv[0][1]; }
        }
    }
};
template <int SECOND> struct EpiMerge {
    static constexpr bool PERM = true, AFTER_DRAIN = false, CHAIN = false;
    const bf16_t* P; bf16_t* Y;
    DI void operator()(const f32x4 (&acc)[2][2][4][2], const pg8::Unit& u, int wr, int wc, int fr, int fq) const {
        const int row0 = CTX + u.pm * 256 + wr * 64 + fr, col0 = u.pn * 256 + wc * 32 + 8 * fq;
#pragma unroll
        for (int ai = 0; ai < 2; ++ai)
#pragma unroll
            for (int m = 0; m < 4; ++m) { const size_t row = (size_t)(row0 + ai * 128 + m * 16);
#pragma unroll
                for (int bj = 0; bj < 2; ++bj) { const int col = col0 + bj * 128;
                    const u32x4 mg = *(const u32x4*)(P + PG(SECOND ? PC_MB : PC_MA) + row * 1024 + col);
                    f32x4 v0 = acc[ai][bj][m][0], v1 = acc[ai][bj][m][1];
                    v0[0] *= sigmoidf_(bflo(mg.x)); v0[1] *= sigmoidf_(bfhi(mg.x)); v0[2] *= sigmoidf_(bflo(mg.y)); v0[3] *= sigmoidf_(bfhi(mg.y));
                    v1[0] *= sigmoidf_(bflo(mg.z)); v1[1] *= sigmoidf_(bfhi(mg.z)); v1[2] *= sigmoidf_(bflo(mg.w)); v1[3] *= sigmoidf_(bfhi(mg.w));
                    bf16_t* yp = Y + row * DM + col;
                    if (SECOND) { const u32x4 o = *(const u32x4*)yp;
                        v0[0] += bflo(o.x); v0[1] += bfhi(o.x); v0[2] += bflo(o.y); v0[3] += bfhi(o.y);
                        v1[0] += bflo(o.z); v1[1] += bfhi(o.z); v1[2] += bflo(o.w); v1[3] += bfhi(o.w); }
                    u32x4 w; w.x = pk2(v0[0], v0[1]); w.y = pk2(v0[2], v0[3]); w.z = pk2(v1[0], v1[1]); w.w = pk2(v1[2], v1[3]);
                    *(u32x4*)yp = w; } }
    }
};
struct PairOrder {
    int G, c;
    __device__ void init(int G_, int c_) { G = G_; c = c_; }
    __device__ bool next(int i, pg8::Unit& u) const { const int t = (i >> 1) * G + c; if (t >= (SEQ / 256) * (DM / 256)) return false;
        u.pm = (t >> 2) + ((i & 1) ? 6 * (MB / 256) : 0); u.pn = (t & 3) + ((i & 1) ? 4 : 0); return true; }
    __device__ __forceinline__ void a_ready(const pg8::Unit&) const {}
    __device__ __forceinline__ void done(const pg8::Unit&) const {}
};
struct EpiMergeF {
    static constexpr bool PERM = true, AFTER_DRAIN = false, CHAIN = true;
    const bf16_t* P; bf16_t* Y;
    DI bool run(f32x4 (&acc)[2][2][4][2], const pg8::Unit& u, int wr, int wc, int fr, int fq) const {
        const bool second = u.pn >= 4;
        const int pm = second ? u.pm - 6 * (MB / 256) : u.pm, pn = second ? u.pn - 4 : u.pn;
        const int row0 = CTX + pm * 256 + wr * 64 + fr, col0 = pn * 256 + wc * 32 + 8 * fq;
#pragma unroll
        for (int ai = 0; ai < 2; ++ai)
#pragma unroll
            for (int m = 0; m < 4; ++m) { const size_t row = (size_t)(row0 + ai * 128 + m * 16);
#pragma unroll
                for (int bj = 0; bj < 2; ++bj) { const int col = col0 + bj * 128;
                    const u32x4 mb = *(const u32x4*)(P + PG(PC_MB) + row * 1024 + col);
                    float eb[8] = {__expf(-fmaxf(bflo(mb.x), -60.f)), __expf(-fmaxf(bfhi(mb.x), -60.f)), __expf(-fmaxf(bflo(mb.y), -60.f)), __expf(-fmaxf(bfhi(mb.y), -60.f)),
                                   __expf(-fmaxf(bflo(mb.z), -60.f)), __expf(-fmaxf(bfhi(mb.z), -60.f)), __expf(-fmaxf(bflo(mb.w), -60.f)), __expf(-fmaxf(bfhi(mb.w), -60.f))};
                    f32x4 v0 = acc[ai][bj][m][0], v1 = acc[ai][bj][m][1];
                    if (!second) { const u32x4 ma = *(const u32x4*)(P + PG(PC_MA) + row * 1024 + col);
                        v0[0] *= sigmoidf_(bflo(ma.x)) * (1.0f + eb[0]); v0[1] *= sigmoidf_(bfhi(ma.x)) * (1.0f + eb[1]); v0[2] *= sigmoidf_(bflo(ma.y)) * (1.0f + eb[2]); v0[3] *= sigmoidf_(bfhi(ma.y)) * (1.0f + eb[3]);
                        v1[0] *= sigmoidf_(bflo(ma.z)) * (1.0f + eb[4]); v1[1] *= sigmoidf_(bfhi(ma.z)) * (1.0f + eb[5]); v1[2] *= sigmoidf_(bflo(ma.w)) * (1.0f + eb[6]); v1[3] *= sigmoidf_(bfhi(ma.w)) * (1.0f + eb[7]);
                        acc[ai][bj][m][0] = v0; acc[ai][bj][m][1] = v1;
                    } else {
                        v0[0] *= __builtin_amdgcn_rcpf(1.0f + eb[0]); v0[1] *= __builtin_amdgcn_rcpf(1.0f + eb[1]); v0[2] *= __builtin_amdgcn_rcpf(1.0f + eb[2]); v0[3] *= __builtin_amdgcn_rcpf(1.0f + eb[3]);
                        v1[0] *= __builtin_amdgcn_rcpf(1.0f + eb[4]); v1[1] *= __builtin_amdgcn_rcpf(1.0f + eb[5]); v1[2] *= __builtin_amdgcn_rcpf(1.0f + eb[6]); v1[3] *= __builtin_amdgcn_rcpf(1.0f + eb[7]);
                        u32x4 w; w.x = pk2(v0[0], v0[1]); w.y = pk2(v0[2], v0[3]); w.z = pk2(v1[0], v1[1]); w.w = pk2(v1[2], v1[3]);
                        *(u32x4*)(Y + row * DM + col) = w; } } }
        return !second;
    }
};
struct EpiOut {
    static constexpr bool PERM = false, AFTER_DRAIN = false, CHAIN = false;
    const float* xl_src; float* xl_dst; const float* gate_lat;
    DI void operator()(const f32x4 (&acc)[2][2][4][2], const pg8::Unit& u, int wr, int wc, int fr, int fq) const {
        const int row0 = u.pm * 256 + wr * 64 + fr, col0 = u.pn * 256 + wc * 32 + 4 * fq;
        f32x4 gv[2][2];
#pragma unroll
        for (int bj = 0; bj < 2; ++bj)
#pragma unroll
            for (int n = 0; n < 2; ++n) gv[bj][n] = *(const f32x4*)(gate_lat + col0 + bj * 128 + n * 16);
#pragma unroll
        for (int ai = 0; ai < 2; ++ai)
#pragma unroll
            for (int m = 0; m < 4; ++m) { const size_t off = (size_t)(row0 + ai * 128 + m * 16) * DM + col0;
#pragma unroll
                for (int bj = 0; bj < 2; ++bj)
#pragma unroll
                    for (int n = 0; n < 2; ++n) { const f32x4 xo = *(const f32x4*)(xl_src + off + bj * 128 + n * 16);
                        *(f32x4*)(xl_dst + off + bj * 128 + n * 16) = xo + gv[bj][n] * acc[ai][bj][m][n]; } }
    }
};
template <int MODE> DI void ctx_patch(lds_t* L, const bf16_t* A0, const bf16_t* B0t, const bf16_t* A1, const bf16_t* B1t, const bf16_t* Ma, const bf16_t* Mb, bf16_t* Y,
                                      const float* xsrc, float* xdst, const float* gate) {
    const int tid = opaque_tid(), wid = tid >> 6, lane = tid & 63, g = lane >> 4, l15 = lane & 15;
    constexpr int NP = MODE == 0 ? 2 : 1;
    for (int patch = blockIdx.x; patch < 256; patch += gridDim.x) {
        const int pr = patch >> 5, pc = patch & 31;
        f32x4 acc[NP][2][2];
#pragma unroll
        for (int part = 0; part < NP; ++part) {
            const bf16_t* A = part ? A1 : A0; const bf16_t* Bt = part ? B1t : B0t;
            bf16x8 Af[2][4], Bf[2][4];
#pragma unroll
            for (int t2 = 0; t2 < 2; ++t2)
#pragma unroll
                for (int ks = 0; ks < 4; ++ks) { Af[t2][ks] = *(const bf16x8*)(A + (size_t)(32 * pr + 16 * t2 + l15) * 1024 + 128 * wid + 32 * ks + 8 * g);
                    Bf[t2][ks] = *(const bf16x8*)(Bt + (size_t)(32 * pc + 16 * t2 + l15) * 1024 + 128 * wid + 32 * ks + 8 * g); }
#pragma unroll
            for (int tm = 0; tm < 2; ++tm)
#pragma unroll
                for (int tn = 0; tn < 2; ++tn) { f32x4 a = (f32x4){0.f, 0.f, 0.f, 0.f};
#pragma unroll
                    for (int ks = 0; ks < 4; ++ks) a = MFMA16(Bf[tn][ks], Af[tm][ks], a);
                    acc[part][tm][tn] = a; }
        }
        __syncthreads();
        LAS f32x4* red = (LAS f32x4*)L;
#pragma unroll
        for (int part = 0; part < NP; ++part)
#pragma unroll
            for (int tm = 0; tm < 2; ++tm)
#pragma unroll
                for (int tn = 0; tn < 2; ++tn) red[((part * 8 + wid) * 4 + tm * 2 + tn) * 64 + lane] = acc[part][tm][tn];
        __syncthreads();
        if (tid < 256) {
            const int tile = tid >> 6, ln = tid & 63, tm = tile >> 1, tn = tile & 1;
            f32x4 s0 = (f32x4){0.f, 0.f, 0.f, 0.f}, s1 = s0;
#pragma unroll
            for (int w = 0; w < 8; ++w) { s0 += red[(w * 4 + tile) * 64 + ln]; if (MODE == 0) s1 += red[((8 + w) * 4 + tile) * 64 + ln]; }
            const size_t off = (size_t)(32 * pr + 16 * tm + (ln & 15)) * 1024 + 32 * pc + 16 * tn + 4 * (ln >> 4);
            if (MODE == 0) { const u32x2 ma = *(const u32x2*)(Ma + off), mb = *(const u32x2*)(Mb + off);
                const float y0 = sigmoidf_(bflo(ma.x)) * s0[0] + sigmoidf_(bflo(mb.x)) * s1[0], y1 = sigmoidf_(bfhi(ma.x)) * s0[1] + sigmoidf_(bfhi(mb.x)) * s1[1];
                const float y2 = sigmoidf_(bflo(ma.y)) * s0[2] + sigmoidf_(bflo(mb.y)) * s1[2], y3 = sigmoidf_(bfhi(ma.y)) * s0[3] + sigmoidf_(bfhi(mb.y)) * s1[3];
                u32x2 w; w.x = pk2(y0, y1); w.y = pk2(y2, y3); *(u32x2*)(Y + off) = w; }
            else { const f32x4 xo = *(const f32x4*)(xsrc + off), gv = *(const f32x4*)(gate + 32 * pc + 16 * tn + 4 * (ln >> 4)); *(f32x4*)(xdst + off) = xo + gv * s0; }
        }
        __syncthreads();
    }
}

DI void phase_ada(kparams_t p, lds_t* L, float* mod) {
    const int tid = opaque_tid(), wid = tid >> 6, lane = tid & 63;
    LAS float* sc = (LAS float*)L; LAS float* red = sc + 3072;
    for (int i = tid; i < 3072; i += 512) { const int v = i >> 10, k = i & 1023; const float c = (v < 2) ? p->c[v * 1024 + k] : p->c_ctx[k]; sc[i] = siluf_(c); }
    __syncthreads();
    for (int it = blockIdx.x; it < DEPTH * 48; it += gridDim.x) {
        const int l = it / 48, cgp = it % 48, n = cgp * 64 + lane;
        const float* W = p->w_ada + (size_t)l * 1024 * 3072 + n;
        float a0 = 0.f, a1 = 0.f, a2 = 0.f;
#pragma unroll 8
        for (int kk = 0; kk < 128; ++kk) { const int k = wid * 128 + kk; const float w = W[(size_t)k * 3072]; a0 += sc[k] * w; a1 += sc[1024 + k] * w; a2 += sc[2048 + k] * w; }
        red[(wid * 3 + 0) * 64 + lane] = a0; red[(wid * 3 + 1) * 64 + lane] = a1; red[(wid * 3 + 2) * 64 + lane] = a2;
        __syncthreads();
        if (tid < 192) { const int v = tid >> 6, ln = tid & 63; float s = 0.f;
#pragma unroll
            for (int w = 0; w < 8; ++w) s += red[(w * 3 + v) * 64 + ln];
            const int nn = cgp * 64 + ln; mod[(l * 3 + v) * 3072 + nn] = s + p->b_ada[l * 3072 + nn]; }
        __syncthreads();
    }
}

DI void transpose_item(const float* W, int ldw, int k0, int c0, bf16_t* WT, int n0, LAS float* scr, int lane) {
#pragma unroll 8
    for (int i = 0; i < 32; ++i) { const int kk = 2 * i + (lane >> 5); scr[kk * 33 + (lane & 31)] = W[(size_t)(k0 + kk) * ldw + c0 + (lane & 31)]; }
    asm volatile("s_waitcnt lgkmcnt(0)" ::: "memory");
    const int c = lane & 7;
#pragma unroll
    for (int j = 0; j < 4; ++j) { const int n = (lane >> 3) + 8 * j; const LAS float* s = scr + (8 * c) * 33 + n;
        u32x4 o; o.x = pk2(s[0 * 33], s[1 * 33]); o.y = pk2(s[2 * 33], s[3 * 33]); o.z = pk2(s[4 * 33], s[5 * 33]); o.w = pk2(s[6 * 33], s[7 * 33]);
        *(u32x4*)(WT + (size_t)(n0 + n) * 1024 + k0 + 8 * c) = o; }
    asm volatile("s_waitcnt lgkmcnt(0)" ::: "memory");
}
DI void phase_wconv(kparams_t p, lds_t* L, int l, bf16_t* BtIn, bf16_t* BtA, bf16_t* BtB, bf16_t* BtO, float* bias2) {
    const int tid = opaque_tid(), wid = tid >> 6, lane = tid & 63;
    LAS float* scr = (LAS float*)(L + wid * 8448);
    const float* Win = p->w_in + (size_t)l * 1024 * NIN_W;
    const int gw = blockIdx.x * 8 + wid, NGW = gridDim.x * 8;
    constexpr int I_IN = 384 * 16, I_SQ = 32 * 16;
    for (int it = gw; it < I_IN + 3 * I_SQ; it += NGW) {
        if (it < I_IN) { const int nb = it >> 4, kb = it & 15, n0 = 32 * nb; transpose_item(Win, NIN_W, 64 * kb, n0 < 5120 ? n0 : n0 + 16, BtIn, n0, scr, lane); }
        else { int r = it - I_IN; const int m = r / I_SQ; r -= m * I_SQ; const int nb = r >> 4, kb = r & 15;
            const float* W = (m == 0 ? p->w_a : m == 1 ? p->w_b : p->w_out) + (size_t)l * 1024 * 1024; bf16_t* WT = m == 0 ? BtA : m == 1 ? BtB : BtO;
            transpose_item(W, 1024, 64 * kb, 32 * nb, WT, 32 * nb, scr, lane); }
    }
    const int gt = blockIdx.x * 512 + tid, NGT = gridDim.x * 512;
    for (int i = gt; i < 256 * 1024; i += NGT) { const int n = 12288 + (i >> 10), k = i & 1023; const float v = (n < 12304) ? Win[(size_t)k * NIN_W + 5120 + (n - 12288)] : 0.f; BtIn[(size_t)n * 1024 + k] = f2bf(v); }
    const float* bi = p->b_in + (size_t)l * NIN_W;
    for (int i = gt; i < NPAD; i += NGT) bias2[i] = i < 5120 ? bi[i] : i < 12288 ? bi[i + 16] : i < 12304 ? bi[5120 + i - 12288] : 0.f;
}

DI void phase_norm(kparams_t p, int l, int b, const float* xl, const float* xc, const float* mod, bf16_t* hA) {
    const int tid_ = opaque_tid(), wid = tid_ >> 6, lane = tid_ & 63;
    const float* gn = p->g_norm + l * 1024;
    for (int r = blockIdx.x * 8 + wid; r < MB; r += gridDim.x * 8) {
        const float* src = r < 256 ? xc + (size_t)r * DM : xl + (size_t)(r - 256) * DM;
        const float* md = mod + (l * 3 + (r < 256 ? 2 : b)) * 3072;
        f32x4 v[4]; float s = 0.f;
#pragma unroll
        for (int j = 0; j < 4; ++j) { v[j] = *(const f32x4*)(src + 4 * lane + 256 * j); s += v[j][0] * v[j][0] + v[j][1] * v[j][1] + v[j][2] * v[j][2] + v[j][3] * v[j][3]; }
        const float rs = rsqrtf(wave_sum(s) * (1.f / DM) + EPS);
#pragma unroll
        for (int j = 0; j < 4; ++j) { const int i = 4 * lane + 256 * j;
            const f32x4 g = *(const f32x4*)(gn + i), sh = *(const f32x4*)(md + i), scl = *(const f32x4*)(md + 1024 + i);
            const f32x4 y = (v[j] * rs * g) * (scl + 1.0f) + sh;
            u32x2 w; w.x = pk2(y[0], y[1]); w.y = pk2(y[2], y[3]); *(u32x2*)(hA + (size_t)r * DM + i) = w; }
    }
}

DI void phase_conv(kparams_t p, int l, const bf16_t* P, bf16_t* QKc) {
    const int tid = opaque_tid(), cgp = tid & 255, sub = tid >> 8, c0 = 8 * cgp;
    const float* wc = p->w_conv + (size_t)l * 9 * 2048 + c0; const float* bc = p->b_conv + l * 2048 + c0;
    float w[9][8], bias[8];
#pragma unroll
    for (int a = 0; a < 9; ++a) { const f32x4 lo = *(const f32x4*)(wc + a * 2048), hi = *(const f32x4*)(wc + a * 2048 + 4);
#pragma unroll
        for (int i = 0; i < 4; ++i) { w[a][i] = lo[i]; w[a][4 + i] = hi[i]; } }
    { const f32x4 lo = *(const f32x4*)bc, hi = *(const f32x4*)(bc + 4);
#pragma unroll
      for (int i = 0; i < 4; ++i) { bias[i] = lo[i]; bias[4 + i] = hi[i]; } }
    const float oscale = c0 >= 1024 ? 0.0625f : 1.0f;
    for (int rp = blockIdx.x; rp < MB / 2; rp += gridDim.x) {
        const int r = 2 * rp + sub;
        float acc[8];
#pragma unroll
        for (int i = 0; i < 8; ++i) acc[i] = bias[i];
        if (r >= 256) {
            const int t = r - 256, y = t >> 6, x = t & 63;
            u32x4 uu[9]; float wm[9];
#pragma unroll
            for (int a = 0; a < 3; ++a)
#pragma unroll
                for (int bb = 0; bb < 3; ++bb) { const int yy = y + a - 1, xx = x + bb - 1; const bool ok = yy >= 0 && yy < 256 && xx >= 0 && xx < 64;
                    const int yc = min(max(yy, 0), 255), xc = min(max(xx, 0), 63);
                    uu[a * 3 + bb] = *(const u32x4*)(P + PG(c0) + (size_t)(256 + yc * 64 + xc) * 1024 + (c0 & 1023)); wm[a * 3 + bb] = ok ? 1.f : 0.f; }
#pragma unroll
            for (int k = 0; k < 9; ++k) { const u32x4 u = uu[k]; const float m = wm[k];
                acc[0] += (w[k][0] * m) * bflo(u.x); acc[1] += (w[k][1] * m) * bfhi(u.x); acc[2] += (w[k][2] * m) * bflo(u.y); acc[3] += (w[k][3] * m) * bfhi(u.y);
                acc[4] += (w[k][4] * m) * bflo(u.z); acc[5] += (w[k][5] * m) * bfhi(u.z); acc[6] += (w[k][6] * m) * bflo(u.w); acc[7] += (w[k][7] * m) * bfhi(u.w); }
        } else {
#pragma unroll
            for (int bb = 0; bb < 3; ++bb) { const int tt = r + bb - 1;
                if (tt >= 0 && tt < 256) { const u32x4 u = *(const u32x4*)(P + PG(c0) + (size_t)tt * 1024 + (c0 & 1023));
                    acc[0] += w[3 + bb][0] * bflo(u.x); acc[1] += w[3 + bb][1] * bfhi(u.x); acc[2] += w[3 + bb][2] * bflo(u.y); acc[3] += w[3 + bb][3] * bfhi(u.y);
                    acc[4] += w[3 + bb][4] * bflo(u.z); acc[5] += w[3 + bb][5] * bfhi(u.z); acc[6] += w[3 + bb][6] * bflo(u.w); acc[7] += w[3 + bb][7] * bfhi(u.w); } }
        }
#pragma unroll
        for (int i = 0; i < 8; ++i) acc[i] = siluf_(acc[i]) * oscale;
        u32x4 o; o.x = pk2(acc[0], acc[1]); o.y = pk2(acc[2], acc[3]); o.z = pk2(acc[4], acc[5]); o.w = pk2(acc[6], acc[7]);
        *(u32x4*)(QKc + (size_t)r * 2048 + c0) = o;
    }
}

DI void phase_post(kparams_t p, int l, bf16_t* P, const bf16_t* HF, const bf16_t* HB) {
    const int tid_ = opaque_tid(), wid = tid_ >> 6, lane = tid_ & 63;
    const float* ga = p->g_head_a + l * 1024; const float* gb = p->g_head_b + l * 1024;
    for (int r = blockIdx.x * 8 + wid; r < MB; r += gridDim.x * 8) {
        bf16_t* pr = P + (size_t)r * 1024;
        u32x2 ahf[4], ahb[4], aog[4], azz[4], bhf[4], bhb[4], bzz[4];
#pragma unroll
        for (int h = 0; h < 4; ++h) { const int c4 = 256 * h + 4 * lane;
            ahf[h] = *(const u32x2*)(HF + (size_t)r * 1024 + c4); ahb[h] = *(const u32x2*)(HB + (size_t)r * 1024 + c4); aog[h] = *(const u32x2*)(pr + PG(PC_O) + c4); azz[h] = *(const u32x2*)(pr + PG(PC_ZA) + c4);
            bhf[h] = *(const u32x2*)(pr + PG(PC_OF) + c4); bhb[h] = *(const u32x2*)(pr + PG(PC_OB) + c4); bzz[h] = *(const u32x2*)(pr + PG(PC_ZB) + c4); }
#pragma unroll
        for (int h = 0; h < 4; ++h) { const int c4 = 256 * h + 4 * lane;
            const u32x2 hf = ahf[h], hb = ahb[h], og = aog[h], zz = azz[h];
            float hh[4] = {(bflo(hf.x) + bflo(hb.x)) * sigmoidf_(bflo(og.x)), (bfhi(hf.x) + bfhi(hb.x)) * sigmoidf_(bfhi(og.x)), (bflo(hf.y) + bflo(hb.y)) * sigmoidf_(bflo(og.y)), (bfhi(hf.y) + bfhi(hb.y)) * sigmoidf_(bfhi(og.y))};
            const float rs = rsqrtf(wave_sum(hh[0] * hh[0] + hh[1] * hh[1] + hh[2] * hh[2] + hh[3] * hh[3]) * (1.f / 256.f) + EPS);
            const f32x4 g = *(const f32x4*)(ga + c4);
            const float z[4] = {bflo(zz.x), bfhi(zz.x), bflo(zz.y), bfhi(zz.y)};
            float y[4];
#pragma unroll
            for (int i = 0; i < 4; ++i) y[i] = hh[i] * rs * g[i] * siluf_(z[i]);
            u32x2 w; w.x = pk2(y[0], y[1]); w.y = pk2(y[2], y[3]); *(u32x2*)(pr + PG(PC_O) + c4) = w; }
#pragma unroll
        for (int hp = 0; hp < 4; ++hp) { const int c4 = 256 * hp + 4 * lane;
            const u32x2 hf = bhf[hp], hb = bhb[hp], zz = bzz[hp];
            float hh[4] = {bflo(hf.x) + bflo(hb.x), bfhi(hf.x) + bfhi(hb.x), bflo(hf.y) + bflo(hb.y), bfhi(hf.y) + bfhi(hb.y)};
            float s = hh[0] * hh[0] + hh[1] * hh[1] + hh[2] * hh[2] + hh[3] * hh[3];
#pragma unroll
            for (int o = 1; o < 32; o <<= 1) s += shx(s, o);
            const float rs = rsqrtf(s * (1.f / 128.f) + EPS);
            const f32x4 g = *(const f32x4*)(gb + c4);
            const float z[4] = {bflo(zz.x), bfhi(zz.x), bflo(zz.y), bfhi(zz.y)};
            float y[4];
#pragma unroll
            for (int i = 0; i < 4; ++i) y[i] = hh[i] * rs * g[i] * siluf_(z[i]);
            u32x2 w; w.x = pk2(y[0], y[1]); w.y = pk2(y[2], y[3]); *(u32x2*)(pr + PG(PC_ZB) + c4) = w; }
    }
}

DI void phase_final(kparams_t p, float* out) {
    const int tid_ = opaque_tid(), wid = tid_ >> 6, lane = tid_ & 63;
    for (int r = blockIdx.x * 8 + wid; r < NB * SEQ; r += gridDim.x * 8) {
        float* row = out + (size_t)r * DM; f32x4 v[4]; float s = 0.f;
#pragma unroll
        for (int j = 0; j < 4; ++j) { v[j] = *(const f32x4*)(row + 4 * lane + 256 * j); s += v[j][0] * v[j][0] + v[j][1] * v[j][1] + v[j][2] * v[j][2] + v[j][3] * v[j][3]; }
        const float rs = rsqrtf(wave_sum(s) * (1.f / DM) + EPS);
#pragma unroll
        for (int j = 0; j < 4; ++j) { const f32x4 g = *(const f32x4*)(p->g_final + 4 * lane + 256 * j); *(f32x4*)(row + 4 * lane + 256 * j) = v[j] * rs * g; }
    }
}

DI int sc_order(int d, int j) { return d == 0 ? j : (j == 0 ? 0 : NSC - j); }
constexpr int KST = 528;
constexpr int ML_BUFK = 0, ML_BUFV = 64 * KST, ML_F0 = 2 * 64 * KST, ML_F1 = ML_F0 + 1024, ML_F2 = ML_F1 + 1024, ML_F3 = ML_F2 + 1024;

template <int MODE> DI void mlstm_scalars(const float* G, int row0, int h, int d, float m_in, lds_t* L, float& Bout, float& mout) {
    const int lane = opaque_tid() & 63;
    LAS float* F0 = (LAS float*)(L + ML_F0); LAS float* F1 = (LAS float*)(L + ML_F1); LAS float* F2 = (LAS float*)(L + ML_F2);
    float li[4], bb[4]; int rr[4]; float run = 0.f;
#pragma unroll
    for (int i = 0; i < 4; ++i) { const int pp = 4 * lane + i; rr[i] = d ? 255 - pp : pp; const float* gr = G + (size_t)(row0 + rr[i]) * 16;
        li[i] = gr[(2 * d) * 4 + h]; run += logsigmoidf_(gr[(2 * d + 1) * 4 + h]); bb[i] = run; }
    float incl = run;
#pragma unroll
    for (int o = 1; o < 64; o <<= 1) { const float v = shup(incl, o); if (lane >= o) incl += v; }
    const float excl = incl - run; const float B = rdlane63(incl);
#pragma unroll
    for (int i = 0; i < 4; ++i) bb[i] += excl;
    if (MODE == 0) {
        float ws[4], mx = -3.0e38f;
#pragma unroll
        for (int i = 0; i < 4; ++i) { ws[i] = B - bb[i] + li[i]; mx = fmaxf(mx, ws[i]); }
        mx = wave_max(mx);
#pragma unroll
        for (int i = 0; i < 4; ++i) F0[rr[i]] = __expf(ws[i] - mx);
        Bout = B; mout = mx;
    } else {
        float u[4], pm[4], mx = -3.0e38f;
#pragma unroll
        for (int i = 0; i < 4; ++i) { u[i] = li[i] - bb[i]; mx = fmaxf(mx, u[i]); pm[i] = mx; }
        float inc = mx;
#pragma unroll
        for (int o = 1; o < 64; o <<= 1) { const float v = shup(inc, o); if (lane >= o) inc = fmaxf(inc, v); }
        float ex = shup(inc, 1); if (lane == 0) ex = -3.0e38f;
#pragma unroll
        for (int i = 0; i < 4; ++i) { F0[rr[i]] = u[i]; F1[rr[i]] = fmaxf(m_in, fmaxf(ex, pm[i])); F2[rr[i]] = bb[i]; }
        Bout = B; mout = 0.f;
    }
}

DI void mlstm_passA(int item, lds_t* L, const bf16_t* P, const bf16_t* QKc, const float* G, bf16_t* STA, float* NST, float* SCA) {
    const int tid = opaque_tid(), wid = tid >> 6, lane = tid & 63, g = lane >> 4, q4 = (lane >> 2) & 3, p4 = lane & 3, l15 = lane & 15;
    const int j = item % NSC, hd = item / NSC, d = hd & 1, h = hd >> 1, scan = hd, o = sc_order(d, j), row0 = 256 * j;
    constexpr int A_PAIR = 2 * 64 * KST, A_SCAL = 2 * A_PAIR;
    lds_t* LS = L + (A_SCAL - ML_F0);
    u32x4 pk[4], pv[4];
#define MA_LOAD(sb_) do { _Pragma("unroll") for (int it = 0; it < 4; ++it) { const int c = tid + 512 * it, r = c >> 5, c16 = c & 31; const size_t grow = (size_t)(row0 + 64 * (sb_) + r); \
        pk[it] = *(const u32x4*)(QKc + grow * 2048 + 1024 + 256 * h + 8 * c16); pv[it] = *(const u32x4*)(P + PG(PC_V) + grow * 1024 + 256 * h + 8 * c16); } } while (0)
    MA_LOAD(0);
    __syncthreads();
    if (wid == 0) { float Bv, mv; mlstm_scalars<0>(G, row0, h, d, 0.f, LS, Bv, mv); if (lane == 0) { SCA[scan * NSC + o] = Bv; SCA[520 + scan * NSC + o] = mv; } }
    __syncthreads();
    LAS float* WSE = (LAS float*)(LS + ML_F0);
    f32x4 acc[2][16];
#pragma unroll
    for (int a = 0; a < 2; ++a)
#pragma unroll
        for (int n = 0; n < 16; ++n) acc[a][n] = (f32x4){0.f, 0.f, 0.f, 0.f};
    f32x4 nacc[2] = {(f32x4){0.f, 0.f, 0.f, 0.f}, (f32x4){0.f, 0.f, 0.f, 0.f}};
    bf16x8 ones;
#pragma unroll
    for (int i = 0; i < 8; ++i) ones[i] = (short)0x3F80;
    for (int sb = 0; sb < 4; ++sb) {
        const int pb = (sb & 1) * A_PAIR;
#pragma unroll
        for (int it = 0; it < 4; ++it) { const int c = tid + 512 * it, r = c >> 5, c16 = c & 31;
            const u32x4 kv = pk[it]; const float w = WSE[64 * sb + r];
            u32x4 ko; ko.x = pk2(bflo(kv.x) * w, bfhi(kv.x) * w); ko.y = pk2(bflo(kv.y) * w, bfhi(kv.y) * w); ko.z = pk2(bflo(kv.z) * w, bfhi(kv.z) * w); ko.w = pk2(bflo(kv.w) * w, bfhi(kv.w) * w);
            *(LAS u32x4*)(L + pb + ML_BUFK + r * KST + 16 * c16) = ko; *(LAS u32x4*)(L + pb + ML_BUFV + r * KST + 16 * c16) = pv[it]; }
        __syncthreads();
        if (sb < 3) MA_LOAD(sb + 1);
#pragma unroll
        for (int ks = 0; ks < 2; ++ks) {
            lds_t* ka = L + pb + ML_BUFK + (32 * ks + 8 * g + q4) * KST + (32 * wid + 4 * p4) * 2;
            const bf16x8 A0 = mk8(trrd(ka), trrd(ka + 4 * KST)), A1 = mk8(trrd(ka + 32), trrd(ka + 32 + 4 * KST));
            nacc[0] = MFMA16(A0, ones, nacc[0]); nacc[1] = MFMA16(A1, ones, nacc[1]);
            lds_t* va = L + pb + ML_BUFV + (32 * ks + 8 * g + q4) * KST + (4 * p4) * 2;
#pragma unroll
            for (int n = 0; n < 16; ++n) { const bf16x8 Bf = mk8(trrd(va + 32 * n), trrd(va + 32 * n + 4 * KST));
                acc[0][n] = MFMA16(A0, Bf, acc[0][n]); acc[1][n] = MFMA16(A1, Bf, acc[1][n]); }
        }
    }
#undef MA_LOAD
    bf16_t* slot = STA + (size_t)(scan * NSC + o) * 65536;
#pragma unroll
    for (int a = 0; a < 2; ++a)
#pragma unroll
        for (int n = 0; n < 16; ++n) { u32x2 w; w.x = pk2(acc[a][n][0], acc[a][n][1]); w.y = pk2(acc[a][n][2], acc[a][n][3]);
            *(u32x2*)(slot + (size_t)(16 * n + l15) * 256 + 32 * wid + 16 * a + 4 * g) = w; }
    if (l15 == 0) {
#pragma unroll
        for (int a = 0; a < 2; ++a) *(f32x4*)(NST + (size_t)(scan * NSC + o) * 256 + 32 * wid + 16 * a + 4 * g) = nacc[a]; }
}

DI void mlstm_passB(bf16_t* STA, float* NST, float* SCA) {
    const int gt = blockIdx.x * 512 + opaque_tid(), NGT = gridDim.x * 512;
    for (int idx = gt; idx < 8 * 8192 + 8 * 64; idx += NGT) {
        const bool isn = idx >= 8 * 8192; const int r = isn ? idx - 8 * 8192 : idx; const int scan = isn ? r >> 6 : r >> 13, off = isn ? (r & 63) * 4 : (r & 8191) * 8;
        float run[8], mrun = 0.f;
#pragma unroll
        for (int i = 0; i < 8; ++i) run[i] = 0.f;
        u32x4 nlv[8]; f32x4 nnv[8]; float nBs[8], nmls[8];
#define MB_LOAD(o0_) do { _Pragma("unroll") for (int k = 0; k < 8; ++k) { if (isn) nnv[k] = *(const f32x4*)(NST + (size_t)(scan * NSC + (o0_) + k) * 256 + off); else nlv[k] = *(const u32x4*)(STA + (size_t)(scan * NSC + (o0_) + k) * 65536 + off); \
            nBs[k] = SCA[scan * NSC + (o0_) + k]; nmls[k] = SCA[520 + scan * NSC + (o0_) + k]; } } while (0)
        MB_LOAD(0);
        for (int o0 = 0; o0 < 64; o0 += 8) {
            u32x4 lv[8]; f32x4 nv[8]; float Bs[8], mls[8];
#pragma unroll
            for (int k = 0; k < 8; ++k) { lv[k] = nlv[k]; nv[k] = nnv[k]; Bs[k] = nBs[k]; mls[k] = nmls[k]; }
            if (o0 < 56) MB_LOAD(o0 + 8);
#pragma unroll
            for (int k = 0; k < 8; ++k) { const int o = o0 + k; const float Bv = Bs[k], ml = mls[k];
                const float mn = fmaxf(Bv + mrun, ml), dec = __expf(Bv + mrun - mn), sc = __expf(ml - mn); mrun = mn;
                if (isn) {
#pragma unroll
                    for (int i = 0; i < 4; ++i) run[i] = dec * run[i] + sc * nv[k][i];
                    *(f32x4*)(NST + (size_t)(scan * NSC + o) * 256 + off) = (f32x4){run[0], run[1], run[2], run[3]};
                    if (off == 0) SCA[1040 + scan * NSC + o] = mn;
                } else {
                    run[0] = dec * run[0] + sc * bflo(lv[k].x); run[1] = dec * run[1] + sc * bfhi(lv[k].x); run[2] = dec * run[2] + sc * bflo(lv[k].y); run[3] = dec * run[3] + sc * bfhi(lv[k].y);
                    run[4] = dec * run[4] + sc * bflo(lv[k].z); run[5] = dec * run[5] + sc * bfhi(lv[k].z); run[6] = dec * run[6] + sc * bflo(lv[k].w); run[7] = dec * run[7] + sc * bfhi(lv[k].w);
                    u32x4 w; w.x = pk2(run[0], run[1]); w.y = pk2(run[2], run[3]); w.z = pk2(run[4], run[5]); w.w = pk2(run[6], run[7]);
                    *(u32x4*)(STA + (size_t)(scan * NSC + o) * 65536 + off) = w; } }
        }
#undef MB_LOAD
    }
}

constexpr int MC_PAIR = 2 * 64 * KST, MC_SCAL = 2 * MC_PAIR;
DI void mlstm_passC(int item, lds_t* L, const bf16_t* P, bf16_t* HF, bf16_t* HB, const bf16_t* QKc, const float* G, const bf16_t* STA, const float* NST, const float* SCA) {
    const int tid = opaque_tid(), wid = tid >> 6, lane = tid & 63, g = lane >> 4, q4 = (lane >> 2) & 3, p4 = lane & 3, l15 = lane & 15;
    const int qb = item & 1, it2 = item >> 1, j = it2 % NSC, hd = it2 / NSC, d = hd & 1, h = hd >> 1, scan = hd, o = sc_order(d, j), row0 = 256 * j;
    const float m_in = o > 0 ? SCA[1040 + scan * NSC + o - 1] : 0.f;
    lds_t* LS = L + (MC_SCAL - ML_F0);
    const int trow = 128 * qb + 16 * wid + l15;
    const int kb_lo = d ? 2 * qb : 0, kb_hi = d ? 3 : 2 * qb + 1;
    const bf16_t* sin = STA + (size_t)(scan * NSC + (o > 0 ? o - 1 : 0)) * 65536;
    u32x4 pk[4], pv[4];
#define MC_LOADKV(kb_) do { _Pragma("unroll") for (int it = 0; it < 4; ++it) { const int c = tid + 512 * it, r = c >> 5, c16 = c & 31; const size_t grow = (size_t)(row0 + 64 * (kb_) + r); \
        pk[it] = *(const u32x4*)(QKc + grow * 2048 + 1024 + 256 * h + 8 * c16); pv[it] = *(const u32x4*)(P + PG(PC_V) + grow * 1024 + 256 * h + 8 * c16); } } while (0)
#define MC_LOADC(ep_) do { _Pragma("unroll") for (int it = 0; it < 4; ++it) { const int c = tid + 512 * it, r = c >> 5, c16 = c & 31; \
        pk[it] = *(const u32x4*)(sin + (size_t)(128 * (ep_) + r) * 256 + 8 * c16); pv[it] = *(const u32x4*)(sin + (size_t)(128 * (ep_) + 64 + r) * 256 + 8 * c16); } } while (0)
#define MC_STOREK(pb_) do { _Pragma("unroll") for (int it = 0; it < 4; ++it) { const int c = tid + 512 * it, r = c >> 5, c16 = c & 31; *(LAS u32x4*)(L + (pb_) + ML_BUFK + r * KST + 16 * c16) = pk[it]; } } while (0)
#define MC_STOREV(pb_) do { _Pragma("unroll") for (int it = 0; it < 4; ++it) { const int c = tid + 512 * it, r = c >> 5, c16 = c & 31; *(LAS u32x4*)(L + (pb_) + ML_BUFV + r * KST + 16 * c16) = pv[it]; } } while (0)
    bf16x8 Qf[8];
    { const bf16_t* qp = QKc + (size_t)(row0 + trow) * 2048 + 256 * h + 8 * g;
#pragma unroll
      for (int ks = 0; ks < 8; ++ks) Qf[ks] = *(const bf16x8*)(qp + 32 * ks); }
    if (o > 0) MC_LOADC(0); else MC_LOADKV(kb_lo);
    __syncthreads();
    if (wid == 0) { float Bv, mv; mlstm_scalars<1>(G, row0, h, d, m_in, LS, Bv, mv); }
    LAS float* NIN = (LAS float*)(LS + ML_F3);
    if (tid >= 256) NIN[tid - 256] = o > 0 ? NST[(size_t)(scan * NSC + o - 1) * 256 + tid - 256] : 0.f;
    __syncthreads();
    LAS float* U = (LAS float*)(LS + ML_F0); LAS float* MM = (LAS float*)(LS + ML_F1); LAS float* BBv = (LAS float*)(LS + ML_F2);
    const float Mt = MM[trow], at = __expf(m_in - Mt);
    f32x4 acc[16];
#pragma unroll
    for (int n = 0; n < 16; ++n) acc[n] = (f32x4){0.f, 0.f, 0.f, 0.f};
    if (o > 0) {
#pragma unroll
        for (int ep = 0; ep < 2; ++ep) {
            const int pb = ep * MC_PAIR;
            MC_STOREK(pb); MC_STOREV(pb);
            __syncthreads();
            if (ep < 1) MC_LOADC(1); else MC_LOADKV(kb_lo);
#pragma unroll
            for (int hh = 0; hh < 2; ++hh)
#pragma unroll
                for (int nt = 0; nt < 4; ++nt)
#pragma unroll
                    for (int ks = 0; ks < 8; ++ks) { const bf16x8 Af = *(LAS bf16x8*)(L + pb + (hh ? ML_BUFV : ML_BUFK) + (16 * nt + l15) * KST + (32 * ks + 8 * g) * 2);
                        acc[8 * ep + 4 * hh + nt] = MFMA16(Af, Qf[ks], acc[8 * ep + 4 * hh + nt]); }
        }
#pragma unroll
        for (int n = 0; n < 16; ++n) acc[n] *= at;
    }
    float den = 0.f;
    const int wmin = 128 * qb + 16 * wid, wmax = wmin + 15;
    for (int kb = kb_lo; kb <= kb_hi; ++kb) {
        const int pb = ((kb - kb_lo) & 1) * MC_PAIR;
        MC_STOREK(pb); MC_STOREV(pb);
        __syncthreads();
        if (kb < kb_hi) MC_LOADKV(kb + 1);
#pragma unroll
        for (int ks2 = 0; ks2 < 2; ++ks2) {
            const int s0 = 64 * kb + 32 * ks2;
            const bool skip = d ? (s0 + 31 < wmin) : (s0 > wmax);
            if (!skip) {
                f32x4 wv[2];
#pragma unroll
                for (int tt = 0; tt < 2; ++tt) {
                    wv[tt] = (f32x4){0.f, 0.f, 0.f, 0.f};
                    const bool tskip = d ? (s0 + 16 * tt + 15 < wmin) : (s0 + 16 * tt > wmax);
                    if (!tskip) { f32x4 sa = (f32x4){0.f, 0.f, 0.f, 0.f};
#pragma unroll
                        for (int ks = 0; ks < 8; ++ks) { const bf16x8 Af = *(LAS bf16x8*)(L + pb + ML_BUFK + (32 * ks2 + 16 * tt + l15) * KST + (32 * ks + 8 * g) * 2); sa = MFMA16(Af, Qf[ks], sa); }
                        const int sr = s0 + 16 * tt + 4 * g; const f32x4 us = *(LAS f32x4*)(U + sr);
#pragma unroll
                        for (int jj = 0; jj < 4; ++jj) { const bool ok = d ? (sr + jj >= trow) : (sr + jj <= trow); const float w = ok ? sa[jj] * __expf(us[jj] - Mt) : 0.f; den += w; wv[tt][jj] = w; } } }
                const bf16x8 Pf = pack8(wv[0], wv[1]);
                lds_t* va = L + pb + ML_BUFV + (32 * ks2 + 4 * g + q4) * KST + (4 * p4) * 2;
#pragma unroll
                for (int n = 0; n < 16; ++n) { const bf16x8 Vf = mk8(trrd(va + 32 * n), trrd(va + 32 * n + 16 * KST)); acc[n] = MFMA16(Vf, Pf, acc[n]); }
            }
        }
    }
#undef MC_LOADKV
#undef MC_LOADC
#undef MC_STOREK
#undef MC_STOREV
    den += shx(den, 16); den += shx(den, 32);
    float qn = 0.f;
#pragma unroll
    for (int ks = 0; ks < 8; ++ks) { const f32x4 n0 = *(LAS f32x4*)(NIN + 32 * ks + 8 * g), n1 = *(LAS f32x4*)(NIN + 32 * ks + 8 * g + 4); const u32x4 qw = __builtin_bit_cast(u32x4, Qf[ks]);
        qn += bflo(qw.x) * n0[0] + bfhi(qw.x) * n0[1] + bflo(qw.y) * n0[2] + bfhi(qw.y) * n0[3] + bflo(qw.z) * n1[0] + bfhi(qw.z) * n1[1] + bflo(qw.w) * n1[2] + bfhi(qw.w) * n1[3]; }
    qn += shx(qn, 16); qn += shx(qn, 32);
    den += __expf(m_in - Mt) * qn;
    const float inv = 1.0f / fmaxf(fabsf(den), __expf(-(BBv[trow] + Mt)));
    bf16_t* hp = (d ? HB : HF) + (size_t)(row0 + trow) * 1024 + 256 * h + 4 * g;
#pragma unroll
    for (int n = 0; n < 16; ++n) { u32x2 w; w.x = pk2(acc[n][0] * inv, acc[n][1] * inv); w.y = pk2(acc[n][2] * inv, acc[n][3] * inv); *(u32x2*)(hp + 16 * n) = w; }
}

constexpr int HST = 272;
typedef float f32x2v __attribute__((ext_vector_type(2)));
DI f32x2v mkf2(float a, float b) { f32x2v r = {a, b}; return r; }
constexpr int HG_PT = 0, HG_DEC = 2048, HG_EM = 2560, HG_EL = 3072, HG_QT = 3584, HG_KT = HG_QT + 32 * HST, HG_VV = HG_KT + 32 * HST;
constexpr int HG_SZ = HG_VV + 32 * HST;
template <bool OUT> DI void hgrn_item(int pair, lds_t* L0, bf16_t* P, bf16_t* STB, float* GSUM, const float* lbs) {
    const int tid = opaque_tid(), half = tid >> 8, lt = tid & 255, wl = lt >> 6, lane = tid & 63, g = lane >> 4, q4 = (lane >> 2) & 3, p4 = lane & 3, l15 = lane & 15;
    const int item = 2 * pair + half;
    lds_t* L = L0 + half * HG_SZ;
    const int j = item % NSC, hd = item / NSC, d = hd & 1, hb = hd >> 1, scan = hd, o = sc_order(d, j), row0 = 256 * j;
    const int cp = lane, c0 = 2 * cp, part = wl;
    const size_t fcol = PG(d ? PC_FB : PC_FF) + 128 * hb;
    const size_t ocol = PG(d ? PC_OB : PC_OF) + 128 * hb;
    const float lb0 = lbs[128 * hb + c0], lb1 = lbs[128 * hb + c0 + 1], om0 = 1.0f - lb0, om1 = 1.0f - lb1;
    LAS float* PT = (LAS float*)(L + HG_PT); LAS float* DEC = (LAS float*)(L + HG_DEC); LAS float* EM = (LAS float*)(L + HG_EM); LAS float* EL = (LAS float*)(L + HG_EL);
    f32x4 Sacc[2][8];
#pragma unroll
    for (int es = 0; es < 2; ++es) {
        if (OUT && o > 0) { const bf16_t* sin = STB + (size_t)(scan * NSC + o - 1) * 16384 + (size_t)(16 * (2 * wl + es) + l15) * 128 + 4 * g;
#pragma unroll
            for (int ct = 0; ct < 8; ++ct) { const u32x2 w = *(const u32x2*)(sin + 16 * ct); Sacc[es][ct] = (f32x4){bflo(w.x), bfhi(w.x), bflo(w.y), bfhi(w.y)}; }
        } else {
#pragma unroll
            for (int ct = 0; ct < 8; ++ct) Sacc[es][ct] = (f32x4){0.f, 0.f, 0.f, 0.f};
        }
    }
    float gsum0 = 0.f, gsum1 = 0.f;
    unsigned rf[8], rq[8]; u32x4 rv[2];
    const int vr = lt >> 4, vc16 = lt & 15;
#define HG_ROW(ch, i) (row0 + (d ? 255 - (32 * (ch) + (i)) : 32 * (ch) + (i)))
#define HG_LOAD(ch) do { _Pragma("unroll") for (int ii = 0; ii < 8; ++ii) { const bf16_t* pr = P + (size_t)HG_ROW(ch, 8 * part + ii) * 1024; rf[ii] = *(const unsigned*)(pr + fcol + c0); if (OUT) rq[ii] = *(const unsigned*)(pr + PG(PC_QB) + 128 * hb + c0); } \
        _Pragma("unroll") for (int v2 = 0; v2 < 2; ++v2) rv[v2] = *(const u32x4*)(P + PG(PC_IB) + (size_t)HG_ROW(ch, vr + 16 * v2) * 1024 + 128 * hb + 8 * vc16); } while (0)
    HG_LOAD(0);
    for (int ch = 0; ch < 8; ++ch) {
        float kk0[8], kk1[8], cs0[8], cs1[8]; float run0 = 0.f, run1 = 0.f;
#pragma unroll
        for (int ii = 0; ii < 8; ++ii) {
            { const float e = __expf(-bflo(rf[ii])), f = lb0 + om0 * __builtin_amdgcn_rcpf(1.0f + e); run0 += __builtin_amdgcn_logf(f); cs0[ii] = run0; kk0[ii] = 1.0f - f; }
            { const float e = __expf(-bfhi(rf[ii])), f = lb1 + om1 * __builtin_amdgcn_rcpf(1.0f + e); run1 += __builtin_amdgcn_logf(f); cs1[ii] = run1; kk1[ii] = 1.0f - f; } }
        *(LAS f32x2v*)(PT + part * 128 + c0) = mkf2(run0, run1);
        __syncthreads();
        const f32x2v t0 = *(LAS f32x2v*)(PT + c0), t1 = *(LAS f32x2v*)(PT + 128 + c0), t2 = *(LAS f32x2v*)(PT + 256 + c0), t3 = *(LAS f32x2v*)(PT + 384 + c0);
        const float pre0 = part == 0 ? 0.f : part == 1 ? t0.x : part == 2 ? t0.x + t1.x : t0.x + t1.x + t2.x;
        const float pre1 = part == 0 ? 0.f : part == 1 ? t0.y : part == 2 ? t0.y + t1.y : t0.y + t1.y + t2.y;
        const float gm0 = t0.x + t1.x, gm1 = t0.y + t1.y, gL0 = gm0 + t2.x + t3.x, gL1 = gm1 + t2.y + t3.y;
#pragma unroll
        for (int ii = 0; ii < 8; ++ii) { const int i = 8 * part + ii;
            if (!OUT) {
                *(LAS unsigned*)(L + HG_KT + i * HST + 2 * c0) = pk2(kk0[ii] * __builtin_amdgcn_exp2f(gL0 - pre0 - cs0[ii]), kk1[ii] * __builtin_amdgcn_exp2f(gL1 - pre1 - cs1[ii])); }
            float a0 = 0.f, a1 = 0.f;
            if (OUT) { a0 = __builtin_amdgcn_exp2f(__builtin_amdgcn_fmed3f(pre0 + cs0[ii] - gm0, -86.5f, 86.5f)); a1 = __builtin_amdgcn_exp2f(__builtin_amdgcn_fmed3f(pre1 + cs1[ii] - gm1, -86.5f, 86.5f)); }
            if (OUT) { *(LAS unsigned*)(L + HG_QT + i * HST + 2 * c0) = pk2(bflo(rq[ii]) * a0, bfhi(rq[ii]) * a1);
                *(LAS unsigned*)(L + HG_KT + i * HST + 2 * c0) = pk2(kk0[ii] * __builtin_amdgcn_rcpf(a0), kk1[ii] * __builtin_amdgcn_rcpf(a1)); } }
        if (part == 0) { *(LAS f32x2v*)(DEC + c0) = mkf2(__builtin_amdgcn_exp2f(gL0), __builtin_amdgcn_exp2f(gL1)); *(LAS f32x2v*)(EM + c0) = mkf2(__builtin_amdgcn_exp2f(gm0), __builtin_amdgcn_exp2f(gm1));
            *(LAS f32x2v*)(EL + c0) = mkf2(__builtin_amdgcn_exp2f(gL0 - gm0), __builtin_amdgcn_exp2f(gL1 - gm1)); gsum0 += gL0; gsum1 += gL1; }
#pragma unroll
        for (int v2 = 0; v2 < 2; ++v2) *(LAS u32x4*)(L + HG_VV + (vr + 16 * v2) * HST + 16 * vc16) = rv[v2];
        __syncthreads();
        if (ch < 7) HG_LOAD(ch + 1);
        bf16x8 P0, P1;
        if (OUT) {
            f32x4 s00 = (f32x4){0.f, 0.f, 0.f, 0.f}, s01 = s00, s11 = s00;
#pragma unroll
            for (int ks = 0; ks < 4; ++ks) {
                const bf16x8 K0 = *(LAS bf16x8*)(L + HG_KT + l15 * HST + (32 * ks + 8 * g) * 2), K1 = *(LAS bf16x8*)(L + HG_KT + (16 + l15) * HST + (32 * ks + 8 * g) * 2);
                const bf16x8 Q0 = *(LAS bf16x8*)(L + HG_QT + l15 * HST + (32 * ks + 8 * g) * 2), Q1 = *(LAS bf16x8*)(L + HG_QT + (16 + l15) * HST + (32 * ks + 8 * g) * 2);
                s00 = MFMA16(K0, Q0, s00); s01 = MFMA16(K0, Q1, s01); s11 = MFMA16(K1, Q1, s11); }
#pragma unroll
            for (int jj = 0; jj < 4; ++jj) { const bool ok = (4 * g + jj) <= l15; if (!ok) { s00[jj] = 0.f; s11[jj] = 0.f; } }
            P0 = pack8(s00, (f32x4){0.f, 0.f, 0.f, 0.f}); P1 = pack8(s01, s11);
        }
#pragma unroll
        for (int es = 0; es < 2; ++es) {
            const int ecol = 16 * (2 * wl + es);
            if (OUT) {
                lds_t* va = L + HG_VV + (4 * g + q4) * HST + (ecol + 4 * p4) * 2;
                const bf16x8 Vf = mk8(trrd(va), trrd(va + 16 * HST));
                f32x4 o0 = MFMA16(Vf, P0, ((f32x4){0.f, 0.f, 0.f, 0.f})), o1 = MFMA16(Vf, P1, ((f32x4){0.f, 0.f, 0.f, 0.f}));
#pragma unroll
                for (int ks = 0; ks < 4; ++ks) { const f32x4 em0 = *(LAS f32x4*)(EM + 32 * ks + 4 * g), em1 = *(LAS f32x4*)(EM + 32 * ks + 16 + 4 * g);
                    const bf16x8 Sf = pack8(Sacc[es][2 * ks] * em0, Sacc[es][2 * ks + 1] * em1);
                    lds_t* qa = L + HG_QT + l15 * HST + (32 * ks + 4 * g) * 2;
                    const bf16x8 B0 = mk8(*(LAS s16x4*)qa, *(LAS s16x4*)(qa + 32)), B1 = mk8(*(LAS s16x4*)(qa + 16 * HST), *(LAS s16x4*)(qa + 16 * HST + 32));
                    o0 = MFMA16(Sf, B0, o0); o1 = MFMA16(Sf, B1, o1); }
                { u32x2 w; w.x = pk2(o0[0], o0[1]); w.y = pk2(o0[2], o0[3]); *(u32x2*)(P + (size_t)HG_ROW(ch, l15) * 1024 + ocol + ecol + 4 * g) = w;
                  w.x = pk2(o1[0], o1[1]); w.y = pk2(o1[2], o1[3]); *(u32x2*)(P + (size_t)HG_ROW(ch, 16 + l15) * 1024 + ocol + ecol + 4 * g) = w; }
            }
            if (!OUT || ch < 7) {
                lds_t* vb = L + HG_VV + (8 * g + q4) * HST + (ecol + 4 * p4) * 2;
                const bf16x8 Vb = mk8(trrd(vb), trrd(vb + 4 * HST));
                lds_t* kb = L + HG_KT + (8 * g + q4) * HST + (4 * p4) * 2;
#pragma unroll
                for (int ct = 0; ct < 8; ++ct) { const f32x4 dc = *(LAS f32x4*)(DEC + 16 * ct + 4 * g), el = *(LAS f32x4*)(EL + 16 * ct + 4 * g);
                    const bf16x8 Ka = mk8(trrd(kb + 32 * ct), trrd(kb + 32 * ct + 4 * HST));
                    if (OUT) { const f32x4 up = MFMA16(Ka, Vb, ((f32x4){0.f, 0.f, 0.f, 0.f})); Sacc[es][ct] = Sacc[es][ct] * dc + up * el; }
                    else Sacc[es][ct] = MFMA16(Ka, Vb, Sacc[es][ct] * dc); }
            }
        }
        __syncthreads();
    }
    if (!OUT) {
#pragma unroll
        for (int es = 0; es < 2; ++es) { bf16_t* so = STB + (size_t)(scan * NSC + o) * 16384 + (size_t)(16 * (2 * wl + es) + l15) * 128 + 4 * g;
#pragma unroll
            for (int ct = 0; ct < 8; ++ct) { u32x2 w; w.x = pk2(Sacc[es][ct][0], Sacc[es][ct][1]); w.y = pk2(Sacc[es][ct][2], Sacc[es][ct][3]); *(u32x2*)(so + 16 * ct) = w; } }
        if (part == 0) *(f32x2v*)(GSUM + (size_t)(scan * NSC + o) * 128 + c0) = mkf2(gsum0, gsum1);
    }
#undef HG_ROW
#undef HG_LOAD
}

DI void hgrn_passB(bf16_t* STB, const float* GSUM) {
    const int gt = (gridDim.x - 1 - blockIdx.x) * 512 + opaque_tid(), NGT = gridDim.x * 512;
    for (int idx = gt; idx < 16 * 2048; idx += NGT) {
        const int scan = idx >> 11, off = (idx & 2047) * 8, c0 = off & 127;
        float run[8];
#pragma unroll
        for (int i = 0; i < 8; ++i) run[i] = 0.f;
        u32x4 nlv[8]; f32x4 ng0[8], ng1[8];
#define HB_LOAD(o0_) do { _Pragma("unroll") for (int k = 0; k < 8; ++k) { nlv[k] = *(const u32x4*)(STB + (size_t)(scan * NSC + (o0_) + k) * 16384 + off); \
            ng0[k] = *(const f32x4*)(GSUM + (size_t)(scan * NSC + (o0_) + k) * 128 + c0); ng1[k] = *(const f32x4*)(GSUM + (size_t)(scan * NSC + (o0_) + k) * 128 + c0 + 4); } } while (0)
        HB_LOAD(0);
        for (int o0 = 0; o0 < 64; o0 += 8) {
            u32x4 lv[8]; f32x4 g0[8], g1[8];
#pragma unroll
            for (int k = 0; k < 8; ++k) { lv[k] = nlv[k]; g0[k] = ng0[k]; g1[k] = ng1[k]; }
            if (o0 < 56) HB_LOAD(o0 + 8);
#pragma unroll
            for (int k = 0; k < 8; ++k) {
                run[0] = __builtin_amdgcn_exp2f(g0[k][0]) * run[0] + bflo(lv[k].x); run[1] = __builtin_amdgcn_exp2f(g0[k][1]) * run[1] + bfhi(lv[k].x); run[2] = __builtin_amdgcn_exp2f(g0[k][2]) * run[2] + bflo(lv[k].y); run[3] = __builtin_amdgcn_exp2f(g0[k][3]) * run[3] + bfhi(lv[k].y);
                run[4] = __builtin_amdgcn_exp2f(g1[k][0]) * run[4] + bflo(lv[k].z); run[5] = __builtin_amdgcn_exp2f(g1[k][1]) * run[5] + bfhi(lv[k].z); run[6] = __builtin_amdgcn_exp2f(g1[k][2]) * run[6] + bflo(lv[k].w); run[7] = __builtin_amdgcn_exp2f(g1[k][3]) * run[7] + bfhi(lv[k].w);
                u32x4 w; w.x = pk2(run[0], run[1]); w.y = pk2(run[2], run[3]); w.z = pk2(run[4], run[5]); w.w = pk2(run[6], run[7]);
                *(u32x4*)(STB + (size_t)(scan * NSC + o0 + k) * 16384 + off) = w; }
        }
    }
}

constexpr size_t OFF_LBS = WS_END;
constexpr size_t OFF_BAR = OFF_LBS + 4 * 1024 * 4;
constexpr size_t WS_TOTAL = OFF_BAR + 32768;


#define XB_TMO      128
#define XB_XCNT(j)  (256  + 64 * (j))
#define XB_XSUB(j)  (1280 + 64 * (j))
#define XB_XGEN(j)  (2304 + 64 * (j))
#define XB_TOP      3328
#define XB_TOPGEN   3392
#define XCD_BAR_WORDS 3456
#define XB_SPIN_CAP (1u << 22)
DI unsigned xb_ld(unsigned* p)              { return __hip_atomic_load(p, __ATOMIC_RELAXED, __HIP_MEMORY_SCOPE_AGENT); }
DI unsigned xb_add(unsigned* p, unsigned v) { return __hip_atomic_fetch_add(p, v, __ATOMIC_RELAXED, __HIP_MEMORY_SCOPE_AGENT); }
DI unsigned xb_xcc_id() { return (unsigned)__builtin_amdgcn_s_getreg((3 << 11) | 20) & 0xFu; }
#define XB_SPIN(cond, bar) do { unsigned _sp = 0; while (cond) { __builtin_amdgcn_s_sleep(1); \
    if ((++_sp & 255u) == 0u) { if (xb_ld(&(bar)[XB_TMO])) break; if (_sp > XB_SPIN_CAP) { atomicAdd(&(bar)[XB_TMO], 1u); break; } } } } while (0)
struct XcdBarrier { unsigned* bar; unsigned x; volatile LAS unsigned* st; };
DI XcdBarrier xcd_barrier_post(unsigned* bar, volatile LAS unsigned* st) {
    XcdBarrier b; b.bar = bar; b.x = xb_xcc_id(); b.st = st;
    if (threadIdx.x == 0) (void)xb_add(&bar[XB_XCNT(b.x)], 1u);
    return b;
}
DI void xcd_barrier_complete(unsigned* bar, unsigned x, unsigned& nloc, unsigned& nx) {
    const unsigned G = gridDim.x * gridDim.y * gridDim.z;
    unsigned sum, cnt, mine, sp = 0u;
    for (;;) {
        sum = 0u; cnt = 0u; mine = 0u;
#pragma unroll
        for (unsigned j = 0; j < 16; ++j) { const unsigned c = xb_ld(&bar[XB_XCNT(j)]); sum += c; cnt += (c > 0u) ? 1u : 0u; mine = (j == x) ? c : mine; }
        if (sum == G) break;
        __builtin_amdgcn_s_sleep(1);
        if ((++sp & 255u) == 0u) { if (xb_ld(&bar[XB_TMO])) break; if (sp > XB_SPIN_CAP) { atomicAdd(&bar[XB_TMO], 1u); break; } }
    }
    nloc = mine > 0u ? mine : 1u; nx = cnt > 0u ? cnt : 1u;
}
DI void xcd_barrier(const XcdBarrier& b) {
    asm volatile("s_waitcnt vmcnt(0) lgkmcnt(0)" ::: "memory");
    __syncthreads();
    if (threadIdx.x == 0) {
        unsigned* bar = b.bar;
        __builtin_amdgcn_s_waitcnt(0);
        unsigned nloc = b.st[0], nx = b.st[1];
        if (nloc == 0u) { xcd_barrier_complete(bar, b.x, nloc, nx); b.st[0] = nloc; b.st[1] = nx; }
        const unsigned old = xb_add(&bar[XB_XSUB(b.x)], 1u);
        const unsigned gen = old / nloc;
        if (old + 1u == (gen + 1u) * nloc) {
            __builtin_amdgcn_fence(__ATOMIC_RELEASE, "agent");
            asm volatile("s_waitcnt vmcnt(0)" ::: "memory");
            const unsigned og = xb_add(&bar[XB_TOP], 1u);
            const unsigned tg = og / nx;
            if (og + 1u == (tg + 1u) * nx) xb_add(&bar[XB_TOPGEN], 1u);
            else XB_SPIN(xb_ld(&bar[XB_TOPGEN]) == tg, bar);
            __builtin_amdgcn_fence(__ATOMIC_ACQUIRE, "agent");
            xb_add(&bar[XB_XGEN(b.x)], 1u);
            asm volatile("s_waitcnt vmcnt(0)" ::: "memory");
        } else {
            XB_SPIN(xb_ld(&bar[XB_XGEN(b.x)]) == gen, bar);
            __builtin_amdgcn_fence(__ATOMIC_ACQUIRE, "agent");
            asm volatile("s_waitcnt vmcnt(0)" ::: "memory");
        }
    }
    __syncthreads();
}
DI kparams_t ldp() { kparams_t k = (kparams_t)__builtin_amdgcn_kernarg_segment_ptr(); asm volatile("" : "+s"(k)); return k; }
#define WSP(type, off) ((type*)(q->ws + (off)))
#ifndef REP_H
#define REP_H 1
#endif
#ifndef REP_M
#define REP_M 1
#endif
#ifndef REP_G
#define REP_G 1
#endif
#ifndef REP_T
#define REP_T 1
#endif
#ifndef REP_B
#define REP_B 1
#endif
#ifndef REP_X
#define REP_X 1
#endif
#ifndef DUMP
#define DUMP 0
#endif

__global__ void __launch_bounds__(512, 2) fwd_megakernel(Params p_unused) {
    extern __shared__ __attribute__((aligned(16))) unsigned char lds_raw[];
    lds_t* L = (lds_t*)lds_raw;
    cg::grid_group grid = cg::this_grid();
    volatile LAS unsigned* bst = (volatile LAS unsigned*)(L + LDS_BYTES - 16);
    if (threadIdx.x < 4) bst[threadIdx.x] = 0u;
    __syncthreads();
    grid.sync();
    const XcdBarrier xbar = xcd_barrier_post((unsigned*)(ldp()->ws + OFF_BAR), bst);
#define GSYNC() for (int rb_ = 0; rb_ < REP_B; ++rb_) xcd_barrier(xbar)
    volatile LAS int* wqw = (volatile LAS int*)(L + LDS_BYTES - 32);
#define WQ_BEGIN(ctr_, n_) { unsigned* wqc_ = (ctr_); int nxt_ = 0; if (threadIdx.x == 0) nxt_ = (int)__hip_atomic_fetch_add(wqc_, 1u, __ATOMIC_RELAXED, __HIP_MEMORY_SCOPE_AGENT); \
        for (;;) { __syncthreads(); if (threadIdx.x == 0) *wqw = nxt_; __syncthreads(); const int u = __builtin_amdgcn_readfirstlane(*wqw); if (u >= (n_)) break; \
            if (threadIdx.x == 0) nxt_ = (int)__hip_atomic_fetch_add(wqc_, 1u, __ATOMIC_RELAXED, __HIP_MEMORY_SCOPE_AGENT);
#define WQ_END() } }

    { kparams_t q = ldp(); float* LBS = WSP(float, OFF_LBS);
      for (int c = blockIdx.x * 512 + threadIdx.x; c < 1024; c += gridDim.x * 512) {
        const float a0 = q->lb_logits[c], a1 = q->lb_logits[1024 + c], a2 = q->lb_logits[2048 + c], a3 = q->lb_logits[3072 + c];
        const float mx = fmaxf(fmaxf(a0, a1), fmaxf(a2, a3)); const float e0 = __expf(a0 - mx), e1 = __expf(a1 - mx), e2 = __expf(a2 - mx), e3 = __expf(a3 - mx); const float inv = 1.0f / (e0 + e1 + e2 + e3);
        LBS[c] = 0.f; LBS[1024 + c] = e1 * inv; LBS[2048 + c] = (e1 + e2) * inv; LBS[3072 + c] = (e1 + e2 + e3) * inv; }
      phase_ada(q, L, WSP(float, OFF_MOD)); }
    GSYNC();

    for (int l = 0; l < DEPTH; ++l) {
        for (int b = 0; b < NB; ++b) {
            { kparams_t q = ldp();
              for (int rep = 0; rep < REP_T; ++rep) if (b == 0) phase_wconv(q, L, l, WSP(bf16_t, OFF_BTIN), WSP(bf16_t, OFF_BTA), WSP(bf16_t, OFF_BTB), WSP(bf16_t, OFF_BTO), WSP(float, OFF_BIAS));
              const float* xl_src = (l == 0 ? q->x : q->out) + (size_t)b * SEQ * DM; const float* xc_src = (l == 0 ? q->ctx : WSP(float, OFF_XC)) + (size_t)b * CTX * DM;
              for (int rep = 0; rep < REP_X; ++rep) phase_norm(q, l, b, xl_src, xc_src, WSP(float, OFF_MOD), WSP(bf16_t, OFF_HA)); }
            GSYNC();
            { kparams_t q = ldp(); pg8::Gemm g{WSP(bf16_t, OFF_HA), WSP(bf16_t, OFF_BTIN), MB, NPAD, DM, DM}; pg8::StaticOrder S; S.init(MB, NPAD, gridDim.x, blockIdx.x);
              EpiIn E{WSP(bf16_t, OFF_P), WSP(float, OFF_G), WSP(float, OFF_BIAS)};
              for (int rep = 0; rep < REP_G; ++rep) pg8::gemm_phase<EpiIn, pg8::StaticOrder>(L, g, S, E); }
            GSYNC();
            { kparams_t q = ldp(); for (int rep = 0; rep < REP_T; ++rep) phase_conv(q, l, WSP(bf16_t, OFF_P), WSP(bf16_t, OFF_QKC)); }
            GSYNC();
            { kparams_t q = ldp();
              unsigned* wqc4 = (unsigned*)(q->ws + OFF_BAR) + 4096 + 64 * (4 * l + 2 * b);
              int nx4 = 0; if (threadIdx.x == 0) nx4 = (int)__hip_atomic_fetch_add(wqc4, 1u, __ATOMIC_RELAXED, __HIP_MEMORY_SCOPE_AGENT);
#define WQ4_DRAW(u_) do { __syncthreads(); if (threadIdx.x == 0) *wqw = nx4; __syncthreads(); (u_) = __builtin_amdgcn_readfirstlane(*wqw); \
        if (threadIdx.x == 0 && (u_) < 16 * NSC) nx4 = (int)__hip_atomic_fetch_add(wqc4, 1u, __ATOMIC_RELAXED, __HIP_MEMORY_SCOPE_AGENT); } while (0)
              int u4; WQ4_DRAW(u4);
              while (u4 < 8 * NSC) { hgrn_item<false>(u4, L, WSP(bf16_t, OFF_P), WSP(bf16_t, OFF_STB), WSP(float, OFF_GSUM), WSP(float, OFF_LBS) + l * 1024); WQ4_DRAW(u4); }
              while (u4 < 16 * NSC) { mlstm_passA(u4 - 8 * NSC, L, WSP(bf16_t, OFF_P), WSP(bf16_t, OFF_QKC), WSP(float, OFF_G), WSP(bf16_t, OFF_STA), WSP(float, OFF_NST), WSP(float, OFF_SCA)); WQ4_DRAW(u4); }
#undef WQ4_DRAW
            }
            GSYNC();
            { kparams_t q = ldp(); mlstm_passB(WSP(bf16_t, OFF_STA), WSP(float, OFF_NST), WSP(float, OFF_SCA)); }
            { kparams_t q = ldp(); hgrn_passB(WSP(bf16_t, OFF_STB), WSP(float, OFF_GSUM)); }
            GSYNC();
            { kparams_t q = ldp();
              unsigned* wqc6 = (unsigned*)(q->ws + OFF_BAR) + 4096 + 64 * (4 * l + 2 * b + 1);
              int nx6 = 0; if (threadIdx.x == 0) nx6 = (int)__hip_atomic_fetch_add(wqc6, 1u, __ATOMIC_RELAXED, __HIP_MEMORY_SCOPE_AGENT);
#define WQ6_DRAW(u_) do { __syncthreads(); if (threadIdx.x == 0) *wqw = nx6; __syncthreads(); (u_) = __builtin_amdgcn_readfirstlane(*wqw); \
        if (threadIdx.x == 0 && (u_) < 24 * NSC) nx6 = (int)__hip_atomic_fetch_add(wqc6, 1u, __ATOMIC_RELAXED, __HIP_MEMORY_SCOPE_AGENT); } while (0)
              int u6; WQ6_DRAW(u6);
              while (u6 < 8 * NSC) { hgrn_item<true>(u6, L, WSP(bf16_t, OFF_P), WSP(bf16_t, OFF_STB), WSP(float, OFF_GSUM), WSP(float, OFF_LBS) + l * 1024); WQ6_DRAW(u6); }
              while (u6 < 24 * NSC) {
                  const int v = u6 - 8 * NSC, it2 = v < 8 * NSC ? v : v - 8 * NSC, dd = (it2 / NSC) & 1, qb = (v < 8 * NSC) ? 1 - dd : dd;
                  mlstm_passC(2 * it2 + qb, L, WSP(bf16_t, OFF_P), WSP(bf16_t, OFF_HA), WSP(bf16_t, OFF_HB2), WSP(bf16_t, OFF_QKC), WSP(float, OFF_G), WSP(bf16_t, OFF_STA), WSP(float, OFF_NST), WSP(float, OFF_SCA));
                  WQ6_DRAW(u6); }
#undef WQ6_DRAW
            }
            GSYNC();
            { kparams_t q = ldp(); phase_post(q, l, WSP(bf16_t, OFF_P), WSP(bf16_t, OFF_HA), WSP(bf16_t, OFF_HB2)); }
            GSYNC();
            { kparams_t q = ldp(); pg8::Gemm g{WSP(bf16_t, OFF_P) + PG(PC_O) + (size_t)CTX * DM, WSP(bf16_t, OFF_BTA), SEQ, DM, DM, DM}; PairOrder S; S.init(gridDim.x, blockIdx.x); EpiMergeF E{WSP(bf16_t, OFF_P), WSP(bf16_t, OFF_HA)};
              pg8::gemm_phase<EpiMergeF, PairOrder>(L, g, S, E); }
            if (l < DEPTH - 1) { kparams_t q = ldp(); const bf16_t* Pp = WSP(bf16_t, OFF_P);
              ctx_patch<0>(L, Pp + PG(PC_O), WSP(bf16_t, OFF_BTA), Pp + PG(PC_ZB), WSP(bf16_t, OFF_BTB), Pp + PG(PC_MA), Pp + PG(PC_MB), WSP(bf16_t, OFF_HA), nullptr, nullptr, nullptr); }
            GSYNC();
            { kparams_t q = ldp(); pg8::Gemm g{WSP(bf16_t, OFF_HA) + (size_t)CTX * DM, WSP(bf16_t, OFF_BTO), SEQ, DM, DM, DM}; pg8::StaticOrder S; S.init(SEQ, DM, gridDim.x, blockIdx.x);
              const float* xl_src = (l == 0 ? q->x : q->out) + (size_t)b * SEQ * DM; float* xl_dst = q->out + (size_t)b * SEQ * DM;
              EpiOut E{xl_src, xl_dst, WSP(float, OFF_MOD) + (l * 3 + b) * 3072 + 2048};
              pg8::gemm_phase<EpiOut, pg8::StaticOrder>(L, g, S, E); }
            if (l < DEPTH - 1) { kparams_t q = ldp();
              const float* xc_src = (l == 0 ? q->ctx : WSP(float, OFF_XC)) + (size_t)b * CTX * DM; float* xc_dst = WSP(float, OFF_XC) + (size_t)b * CTX * DM;
              ctx_patch<1>(L, WSP(bf16_t, OFF_HA), WSP(bf16_t, OFF_BTO), nullptr, nullptr, nullptr, nullptr, nullptr, xc_src, xc_dst, WSP(float, OFF_MOD) + (l * 3 + 2) * 3072 + 2048); }
            GSYNC();
        }
    }
    { kparams_t q = ldp(); phase_final(q, q->out); }
}

extern "C" void kernel_launch(void* const* d_in, const int* in_sizes, int n_in, void* d_out, int out_size, void* d_ws, size_t ws_size, hipStream_t stream) {
    static int grid = 0;
    if (grid == 0) {
        int dev = 0, cus = 0, per_cu = 0;
        if (n_in != 18 || ws_size < WS_TOTAL) { fprintf(stderr, "kernel_launch: unexpected n_in %d / ws_size %zu (need %zu)\n", n_in, ws_size, (size_t)WS_TOTAL); }
        hipGetDevice(&dev); hipDeviceGetAttribute(&cus, hipDeviceAttributeMultiprocessorCount, dev);
        hipFuncSetAttribute((const void*)fwd_megakernel, hipFuncAttributeMaxDynamicSharedMemorySize, LDS_BYTES);
        hipOccupancyMaxActiveBlocksPerMultiprocessor(&per_cu, (const void*)fwd_megakernel, 512, LDS_BYTES);
        if (per_cu < 1) { fprintf(stderr, "kernel_launch: occupancy query gave %d\n", per_cu); per_cu = 1; }
        (void)hipGetLastError();
        grid = cus * per_cu;
    }
    if (ws_size < WS_TOTAL) return;
    Params p; memset(&p, 0, sizeof(p));
    const float** pf = (const float**)&p;
    for (int i = 0; i < 18; ++i) pf[i] = (const float*)d_in[i];
    p.out = (float*)d_out; p.ws = (unsigned char*)d_ws;
    (void)hipMemsetAsync((unsigned char*)d_ws + OFF_BAR, 0, 32768, stream);
    void* args[] = {&p};
    hipError_t e = hipLaunchCooperativeKernel((const void*)fwd_megakernel, dim3(grid), dim3(512), args, LDS_BYTES, stream);
    if (e != hipSuccess) fprintf(stderr, "cooperative launch failed: %s (grid %d)\n", hipGetErrorString(e), grid);
}
```

```cpp
#include <hip/hip_runtime.h>
#include <hip/hip_cooperative_groups.h>
#include <cstdio>
#include <cstring>
namespace cg = cooperative_groups;

#define LAS __attribute__((address_space(3)))
#define DI __device__ __forceinline__
typedef unsigned short bf16_t;
typedef short bf16x8 __attribute__((ext_vector_type(8)));
typedef short s16x4 __attribute__((ext_vector_type(4)));
typedef float f32x4 __attribute__((ext_vector_type(4)));
typedef unsigned u32x4 __attribute__((ext_vector_type(4)));
typedef unsigned u32x2 __attribute__((ext_vector_type(2)));
typedef LAS unsigned char lds_t;
__device__ __forceinline__ int opaque_tid() { int t = threadIdx.x; asm volatile("" : "+v"(t)); return t; }

namespace pg8 {
constexpr int BM = 256, BK = 64, HALF = 128, HTB = HALF * BK * 2, STAGE_BYTES = 8 * HTB, NXCD = 8, WGM = 8;
__host__ __device__ __forceinline__ int lds_byte(int r, int c) { const int st = (r >> 4) * 2 + (c >> 5), rr = r & 15, cc = c & 31, ob = rr * 64 + cc * 2; return st * 1024 + (ob ^ (((ob >> 9) & 1) << 5)); }
__host__ __device__ __forceinline__ void stage_rc(int b, int& R, int& C) { const int st = b / 1024, sb = b % 1024, swz = sb ^ (((sb >> 9) & 1) << 5); R = (st >> 1) * 16 + swz / 64; C = (st & 1) * 32 + (swz % 64) / 2; }
__host__ __device__ __forceinline__ int perm32(int rho) { const int n = rho >> 4, i = rho & 15; return 8 * (i >> 2) + 4 * n + (i & 3); }
struct Unit { int pm, pn; };
struct Gemm { const bf16_t* A; const bf16_t* Bt; int M, N, K, lda; };
struct StaticOrder {
    int nM, nN, nwg, G, c;
    __host__ __device__ void init(int M, int N, int G_, int c_) { nM = M / BM; nN = N / BM; nwg = nM * nN; G = G_; c = c_; }
    __host__ __device__ bool next(int i, Unit& u) const {
        const long L = (long)i * G + c; if (L >= nwg) return false;
        int wgid = (int)L; { const int q = nwg / NXCD, r = nwg % NXCD, xcd = wgid % NXCD, off = wgid / NXCD; wgid = (xcd < r ? xcd * (q + 1) : r * (q + 1) + (xcd - r) * q) + off; }
        const int nig = WGM * nN, gid = wgid / nig, fm = gid * WGM, gsz = (nM - fm) < WGM ? (nM - fm) : WGM;
        u.pm = fm + ((wgid % nig) % gsz); u.pn = (wgid % nig) / gsz; return true;
    }
    __device__ __forceinline__ void a_ready(const Unit&) const {}
    __device__ __forceinline__ void done(const Unit&) const {}
};
typedef float f32x2_ __attribute__((ext_vector_type(2)));
typedef __bf16 bf16x2_ __attribute__((ext_vector_type(2)));
__device__ __forceinline__ unsigned cvt_pk_bf16(float lo, float hi) { const f32x2_ v = {lo, hi}; const bf16x2_ r = __builtin_convertvector(v, bf16x2_); return __builtin_bit_cast(unsigned, r); }

template <class Epi, class Sched>
__device__ __forceinline__ void gemm_phase(lds_t* lds, const Gemm g, const Sched& S, const Epi& E) {
    const int tid = opaque_tid(), wid = __builtin_amdgcn_readfirstlane(tid >> 6), lane = tid & 63, wr = wid >> 2, wc = wid & 3, fr = lane & 15, fq = lane >> 4;
    const int K = g.K, nt = K / BK, lda = g.lda;
    unsigned voffA[2], voffB[2];
#pragma unroll
    for (int i = 0; i < 2; ++i) { int R, C; stage_rc(tid * 16 + i * 8192, R, C); const int Rb = Epi::PERM ? ((R & ~31) + perm32(R & 31)) : R;
        voffA[i] = (unsigned)(R * lda + C) * 2u; voffB[i] = (unsigned)(Rb * K + C) * 2u; }
    const size_t kstep = (size_t)(BK * 2);
    const size_t hstepA = (size_t)HALF * lda * 2, hstepB = (size_t)HALF * K * 2;
    const size_t tstepA = 2 * hstepA, tstepB = 2 * hstepB;
    const unsigned ldsw = (unsigned)wid * 1024u;
    const int aoff = lds_byte(wr * 64 + fr, fq * 8), boff = lds_byte(wc * 32 + fr, fq * 8);
#define PG8_SA(b, h) (((b) * 2 + (h)) * HTB)
#define PG8_SB(b, h) ((4 + (b) * 2 + (h)) * HTB)
#define PG8_STAGE(bufoff, gbase, voff) do { _Pragma("unroll") for (int _i = 0; _i < 2; ++_i) \
        __builtin_amdgcn_global_load_lds((const unsigned*)((const char*)(gbase) + (voff)[_i]), (LAS unsigned*)(lds + (bufoff) + ldsw + _i * 8192), 16, 0, 0); } while (0)
#define PG8_LDA(dst, b, h) do { _Pragma("unroll") for (int m = 0; m < 4; ++m) _Pragma("unroll") for (int k = 0; k < 2; ++k) dst[m][k] = *(const LAS bf16x8*)(lds + PG8_SA(b, h) + aoff + m * 2048 + k * 1024); } while (0)
#define PG8_LDB(dst, b, h) do { _Pragma("unroll") for (int n = 0; n < 2; ++n) _Pragma("unroll") for (int k = 0; k < 2; ++k) dst[n][k] = *(const LAS bf16x8*)(lds + PG8_SB(b, h) + boff + n * 2048 + k * 1024); } while (0)
#define PG8_MMA(ai, bj, At, Bt) do { __builtin_amdgcn_s_setprio(1); _Pragma("unroll") for (int m = 0; m < 4; ++m) _Pragma("unroll") for (int n = 0; n < 2; ++n) _Pragma("unroll") for (int k = 0; k < 2; ++k) \
        acc[ai][bj][m][n] = __builtin_amdgcn_mfma_f32_16x16x32_bf16(Bt[n][k], At[m][k], acc[ai][bj][m][n], 0, 0, 0); __builtin_amdgcn_s_setprio(0); } while (0)
#define PG8_WAIT_V(n) asm volatile("s_waitcnt vmcnt(" #n ")" ::: "memory")
#define PG8_WAIT_L(n) asm volatile("s_waitcnt lgkmcnt(" #n ")" ::: "memory")
#define PG8_BAR __builtin_amdgcn_s_barrier()
#define PG8_SCHED __builtin_amdgcn_sched_barrier(0)
    Unit cur, nxt; int ui = 0;
    if (!S.next(0, cur)) return;
    f32x4 acc[2][2][4][2];
#pragma unroll
    for (int a = 0; a < 2; ++a)
#pragma unroll
        for (int b = 0; b < 2; ++b)
#pragma unroll
            for (int m = 0; m < 4; ++m)
#pragma unroll
                for (int n = 0; n < 2; ++n) acc[a][b][m][n] = (f32x4){0.f, 0.f, 0.f, 0.f};
    bf16x8 At[4][2], B0[2][2], B1[2][2];
    const char* cA = (const char*)g.A + (size_t)cur.pm * tstepA; const char* cB = (const char*)g.Bt + (size_t)cur.pn * tstepB;
    S.a_ready(cur);
    if constexpr (Epi::PREFETCH) E.prefetch(lds, cur, tid);
    PG8_STAGE(PG8_SB(0, 0), cB, voffB); PG8_STAGE(PG8_SA(0, 0), cA, voffA); PG8_STAGE(PG8_SB(0, 1), cB + hstepB, voffB); PG8_STAGE(PG8_SA(0, 1), cA + hstepA, voffA);
    if (wr == 1) PG8_BAR;
    PG8_WAIT_V(4); PG8_BAR;
    PG8_STAGE(PG8_SB(1, 0), cB + kstep, voffB); PG8_STAGE(PG8_SA(1, 0), cA + kstep, voffA); PG8_STAGE(PG8_SB(1, 1), cB + hstepB + kstep, voffB);
    PG8_WAIT_V(6); PG8_BAR;
    for (;;) {
        const bool has_next = S.next(ui + 1, nxt);
        const char* nA = has_next ? (const char*)g.A + (size_t)nxt.pm * tstepA : cA; const char* nB = has_next ? (const char*)g.Bt + (size_t)nxt.pn * tstepB : cB;
        for (int t = 0; t < nt; t += 2) {
            const bool last = (t == nt - 2);
            const char* a1 = cA + (size_t)(t + 1) * kstep;
            const char* a2 = last ? nA : cA + (size_t)(t + 2) * kstep; const char* b2 = last ? nB : cB + (size_t)(t + 2) * kstep;
            const char* a3 = a2 + kstep; const char* b3 = b2 + kstep;
            if (last && has_next) S.a_ready(nxt);
            PG8_LDB(B0, 0, 0); PG8_SCHED; PG8_LDA(At, 0, 0); PG8_STAGE(PG8_SA(1, 1), a1 + hstepA, voffA);
            PG8_WAIT_L(8); PG8_BAR; PG8_WAIT_L(0); PG8_MMA(0, 0, At, B0); PG8_BAR; PG8_SCHED;
            PG8_LDB(B1, 0, 1); PG8_STAGE(PG8_SB(0, 0), b2, voffB);
            PG8_BAR; PG8_WAIT_L(0); PG8_MMA(0, 1, At, B1); PG8_BAR;
            PG8_LDA(At, 0, 1); PG8_STAGE(PG8_SA(0, 0), a2, voffA);
            PG8_BAR; PG8_WAIT_L(0); PG8_MMA(1, 0, At, B0); PG8_BAR; PG8_SCHED;
            PG8_STAGE(PG8_SB(0, 1), b2 + hstepB, voffB);
            PG8_WAIT_V(6); PG8_BAR; PG8_MMA(1, 1, At, B1); PG8_BAR;
            PG8_LDB(B0, 1, 0); PG8_SCHED; PG8_LDA(At, 1, 0); PG8_STAGE(PG8_SA(0, 1), a2 + hstepA, voffA);
            PG8_WAIT_L(8); PG8_BAR; PG8_WAIT_L(0); PG8_MMA(0, 0, At, B0); PG8_BAR; PG8_SCHED;
            PG8_LDB(B1, 1, 1); PG8_STAGE(PG8_SB(1, 0), b3, voffB);
            PG8_BAR; PG8_WAIT_L(0); PG8_MMA(0, 1, At, B1); PG8_BAR;
            PG8_LDA(At, 1, 1); PG8_STAGE(PG8_SA(1, 0), a3, voffA);
            PG8_BAR; PG8_WAIT_L(0); PG8_MMA(1, 0, At, B0); PG8_BAR; PG8_SCHED;
            PG8_STAGE(PG8_SB(1, 1), b3 + hstepB, voffB);
            PG8_WAIT_V(6); PG8_BAR; PG8_MMA(1, 1, At, B1); PG8_BAR;
        }
        bool keep = false;
        if constexpr (Epi::CHAIN) keep = E.run(acc, cur, wr, wc, fr, fq); else E(acc, cur, wr, wc, fr, fq);
        S.done(cur);
        if (!has_next) break;
        if (!keep) {
#pragma unroll
        for (int a = 0; a < 2; ++a)
#pragma unroll
            for (int b = 0; b < 2; ++b)
#pragma unroll
                for (int m = 0; m < 4; ++m)
#pragma unroll
                    for (int n = 0; n < 2; ++n) acc[a][b][m][n] = (f32x4){0.f, 0.f, 0.f, 0.f};
        }
        cur = nxt; cA = nA; cB = nB; ++ui;
    }
    PG8_WAIT_V(0);
    if (wr == 0) PG8_BAR;
    PG8_BAR;
#undef PG8_SA
#undef PG8_SB
#undef PG8_STAGE
#undef PG8_LDA
#undef PG8_LDB
#undef PG8_MMA
#undef PG8_WAIT_V
#undef PG8_WAIT_L
#undef PG8_BAR
#undef PG8_SCHED
}
}

constexpr int DM = 1024, NB = 2, SEQ = 16384, DEPTH = 4, CTX = 256, NIN_W = 12304;
constexpr int MB = CTX + SEQ;
constexpr int NSC = MB / 256;
constexpr int PW = 12288;
constexpr int NPAD = 12544;
constexpr int PC_QK = 0, PC_V = 2048, PC_O = 3072, PC_ZA = 4096, PC_QB = 5120, PC_IB = 6144, PC_FF = 7168, PC_FB = 8192, PC_ZB = 9216, PC_MA = 10240, PC_MB = 11264;
constexpr int PC_OF = 0, PC_OB = 1024;
constexpr float EPS = 1e-6f;
constexpr size_t GS = (size_t)(CTX + SEQ) * 1024;
#define PG(c) ((size_t)((c) >> 10) * GS)

constexpr size_t al256(size_t x) { return (x + 255) & ~(size_t)255; }
constexpr size_t OFF_P = 0;
constexpr size_t OFF_QKC = OFF_P + al256((size_t)MB * PW * 2);
constexpr size_t OFF_HA = OFF_QKC + al256((size_t)MB * 2048 * 2);
constexpr size_t OFF_G = OFF_HA + al256((size_t)MB * DM * 2);
constexpr size_t OFF_BTIN = OFF_G + al256((size_t)MB * 16 * 4);
constexpr size_t OFF_BTA = OFF_BTIN + al256((size_t)NPAD * DM * 2);
constexpr size_t OFF_BTB = OFF_BTA + al256((size_t)DM * DM * 2);
constexpr size_t OFF_BTO = OFF_BTB + al256((size_t)DM * DM * 2);
constexpr size_t OFF_BIAS = OFF_BTO + al256((size_t)DM * DM * 2);
constexpr size_t OFF_STA = OFF_BIAS + al256((size_t)NPAD * 4);
constexpr size_t OFF_NST = OFF_STA + al256((size_t)8 * NSC * 65536 * 2);
constexpr size_t OFF_SCA = OFF_NST + al256((size_t)8 * NSC * 256 * 4);
constexpr size_t OFF_STB = OFF_SCA + 8192;
constexpr size_t OFF_GSUM = OFF_STB + al256((size_t)16 * NSC * 16384 * 2);
constexpr size_t OFF_XC = OFF_GSUM + al256((size_t)16 * NSC * 128 * 4);
constexpr size_t OFF_MOD = OFF_XC + al256((size_t)NB * CTX * DM * 4);
constexpr size_t OFF_HB2 = OFF_MOD + al256((size_t)DEPTH * 3 * 3072 * 4);
constexpr size_t WS_END = OFF_HB2 + al256((size_t)MB * DM * 2);

constexpr int LDS_BYTES = 147456;

struct Params {
    const float *x, *c, *ctx, *c_ctx, *w_ada, *b_ada, *g_norm, *w_in, *b_in, *w_conv, *b_conv, *lb_logits, *g_head_a, *g_head_b, *w_a, *w_b, *w_out, *g_final;
    float* out; unsigned char* ws;
};

typedef const __attribute__((address_space(4))) Params* kparams_t;
DI float bf2f(unsigned short b) { return __uint_as_float(((unsigned)b) << 16); }
DI float bflo(unsigned w) { return __uint_as_float(w << 16); }
DI float bfhi(unsigned w) { return __uint_as_float(w & 0xffff0000u); }
DI unsigned pk2(float lo, float hi) { return pg8::cvt_pk_bf16(lo, hi); }
DI unsigned short f2bf(float f) { return (unsigned short)(pk2(f, 0.f) & 0xffffu); }
DI int lane_id_op() { int l = (int)__builtin_amdgcn_mbcnt_hi(~0u, __builtin_amdgcn_mbcnt_lo(~0u, 0u)); asm volatile("" : "+v"(l)); return l; }
DI float shx(float v, int o) { return __builtin_bit_cast(float, __builtin_amdgcn_ds_bpermute((lane_id_op() ^ o) << 2, __builtin_bit_cast(int, v))); }
DI float shup(float v, int o) { const int l = lane_id_op(); const int src = l >= o ? l - o : l; return __builtin_bit_cast(float, __builtin_amdgcn_ds_bpermute(src << 2, __builtin_bit_cast(int, v))); }
DI float rdlane63(float v) { return __builtin_bit_cast(float, __builtin_amdgcn_readlane(__builtin_bit_cast(int, v), 63)); }
DI float wave_sum(float v) {
#pragma unroll
    for (int o = 1; o < 64; o <<= 1) v += shx(v, o);
    return v;
}
DI float wave_max(float v) {
#pragma unroll
    for (int o = 1; o < 64; o <<= 1) v = fmaxf(v, shx(v, o));
    return v;
}
DI float sigmoidf_(float x) { return 1.0f / (1.0f + __expf(-x)); }
DI float siluf_(float x) { return x / (1.0f + __expf(-x)); }
DI float logsigmoidf_(float x) { return fminf(x, 0.f) - log1pf(__expf(-fabsf(x))); }
DI bf16x8 mk8(s16x4 a, s16x4 b) { bf16x8 r; r[0] = a[0]; r[1] = a[1]; r[2] = a[2]; r[3] = a[3]; r[4] = b[0]; r[5] = b[1]; r[6] = b[2]; r[7] = b[3]; return r; }
DI s16x4 trrd(lds_t* p) { return __builtin_amdgcn_ds_read_tr16_b64_v4i16((LAS s16x4*)p); }
DI bf16x8 pack8(f32x4 a, f32x4 b) { u32x4 w; w.x = pk2(a[0], a[1]); w.y = pk2(a[2], a[3]); w.z = pk2(b[0], b[1]); w.w = pk2(b[2], b[3]); return __builtin_bit_cast(bf16x8, w); }
#define MFMA16(a, b, c) __builtin_amdgcn_mfma_f32_16x16x32_bf16(a, b, c, 0, 0, 0)

struct EpiIn {
    static constexpr bool PERM = true, AFTER_DRAIN = false, CHAIN = false, PREFETCH = false;
    bf16_t* P; float* G; const float* bias;
    DI void operator()(const f32x4 (&acc)[2][2][4][2], const pg8::Unit& u, int wr, int wc, int fr, int fq) const {
        const int row0 = u.pm * 256 + wr * 64 + fr, col0 = u.pn * 256 + wc * 32 + 8 * fq;
        f32x4 bv[2][2];
#pragma unroll
        for (int bj = 0; bj < 2; ++bj)
#pragma unroll
            for (int n = 0; n < 2; ++n) bv[bj][n] = *(const f32x4*)(bias + col0 + bj * 128 + 4 * n);
        if (u.pn < 48) {
#pragma unroll
            for (int ai = 0; ai < 2; ++ai)
#pragma unroll
                for (int m = 0; m < 4; ++m) { bf16_t* rowp = P + (size_t)(u.pn >> 2) * GS + (size_t)(row0 + ai * 128 + m * 16) * 1024 + (col0 & 1023);
#pragma unroll
                    for (int bj = 0; bj < 2; ++bj) { const f32x4 v0 = acc[ai][bj][m][0] + bv[bj][0], v1 = acc[ai][bj][m][1] + bv[bj][1];
                        u32x4 w; w.x = pk2(v0[0], v0[1]); w.y = pk2(v0[2], v0[3]); w.z = pk2(v1[0], v1[1]); w.w = pk2(v1[2], v1[3]);
                        *(u32x4*)(rowp + bj * 128) = w; } }
        } else if (wc == 0 && fq < 2) {
#pragma unroll
            for (int ai = 0; ai < 2; ++ai)
#pragma unroll
                for (int m = 0; m < 4; ++m) { float* gp = G + (size_t)(row0 + ai * 128 + m * 16) * 16 + 8 * fq;
                    *(f32x4*)gp = acc[ai][0][m][0] + bv[0][0]; *(f32x4*)(gp + 4) = acc[ai][0][m][1] + bv[0][1]; }
        }
    }
};
template <int SECOND> struct EpiMerge {
    static constexpr bool PERM = true, AFTER_DRAIN = false, CHAIN = false, PREFETCH = false;
    const bf16_t* P; bf16_t* Y;
    DI void operator()(const f32x4 (&acc)[2][2][4][2], const pg8::Unit& u, int wr, int wc, int fr, int fq) const {
        const int row0 = CTX + u.pm * 256 + wr * 64 + fr, col0 = u.pn * 256 + wc * 32 + 8 * fq;
#pragma unroll
        for (int ai = 0; ai < 2; ++ai)
#pragma unroll
            for (int m = 0; m < 4; ++m) { const size_t row = (size_t)(row0 + ai * 128 + m * 16);
#pragma unroll
                for (int bj = 0; bj < 2; ++bj) { const int col = col0 + bj * 128;
                    const u32x4 mg = *(const u32x4*)(P + PG(SECOND ? PC_MB : PC_MA) + row * 1024 + col);
                    f32x4 v0 = acc[ai][bj][m][0], v1 = acc[ai][bj][m][1];
                    v0[0] *= sigmoidf_(bflo(mg.x)); v0[1] *= sigmoidf_(bfhi(mg.x)); v0[2] *= sigmoidf_(bflo(mg.y)); v0[3] *= sigmoidf_(bfhi(mg.y));
                    v1[0] *= sigmoidf_(bflo(mg.z)); v1[1] *= sigmoidf_(bfhi(mg.z)); v1[2] *= sigmoidf_(bflo(mg.w)); v1[3] *= sigmoidf_(bfhi(mg.w));
                    bf16_t* yp = Y + row * DM + col;
                    if (SECOND) { const u32x4 o = *(const u32x4*)yp;
                        v0[0] += bflo(o.x); v0[1] += bfhi(o.x); v0[2] += bflo(o.y); v0[3] += bfhi(o.y);
                        v1[0] += bflo(o.z); v1[1] += bfhi(o.z); v1[2] += bflo(o.w); v1[3] += bfhi(o.w); }
                    u32x4 w; w.x = pk2(v0[0], v0[1]); w.y = pk2(v0[2], v0[3]); w.z = pk2(v1[0], v1[1]); w.w = pk2(v1[2], v1[3]);
                    *(u32x4*)yp = w; } }
    }
};
struct PairOrder {
    int G, c;
    __device__ void init(int G_, int c_) { G = G_; c = c_; }
    __device__ bool next(int i, pg8::Unit& u) const { const int t = (i >> 1) * G + c; if (t >= (SEQ / 256) * (DM / 256)) return false;
        u.pm = (t >> 2) + ((i & 1) ? 6 * (MB / 256) : 0); u.pn = (t & 3) + ((i & 1) ? 4 : 0); return true; }
    __device__ __forceinline__ void a_ready(const pg8::Unit&) const {}
    __device__ __forceinline__ void done(const pg8::Unit&) const {}
};
struct EpiMergeF {
    static constexpr bool PERM = true, AFTER_DRAIN = false, CHAIN = true, PREFETCH = false;
    const bf16_t* P; bf16_t* Y;
    DI bool run(f32x4 (&acc)[2][2][4][2], const pg8::Unit& u, int wr, int wc, int fr, int fq) const {
        const bool second = u.pn >= 4;
        const int pm = second ? u.pm - 6 * (MB / 256) : u.pm, pn = second ? u.pn - 4 : u.pn;
        const int row0 = CTX + pm * 256 + wr * 64 + fr, col0 = pn * 256 + wc * 32 + 8 * fq;
#pragma unroll
        for (int ai = 0; ai < 2; ++ai)
#pragma unroll
            for (int m = 0; m < 4; ++m) { const size_t row = (size_t)(row0 + ai * 128 + m * 16);
#pragma unroll
                for (int bj = 0; bj < 2; ++bj) { const int col = col0 + bj * 128;
                    const u32x4 mb = *(const u32x4*)(P + PG(PC_MB) + row * 1024 + col);
                    float eb[8] = {__expf(-fmaxf(bflo(mb.x), -60.f)), __expf(-fmaxf(bfhi(mb.x), -60.f)), __expf(-fmaxf(bflo(mb.y), -60.f)), __expf(-fmaxf(bfhi(mb.y), -60.f)),
                                   __expf(-fmaxf(bflo(mb.z), -60.f)), __expf(-fmaxf(bfhi(mb.z), -60.f)), __expf(-fmaxf(bflo(mb.w), -60.f)), __expf(-fmaxf(bfhi(mb.w), -60.f))};
                    f32x4 v0 = acc[ai][bj][m][0], v1 = acc[ai][bj][m][1];
                    if (!second) { const u32x4 ma = *(const u32x4*)(P + PG(PC_MA) + row * 1024 + col);
                        v0[0] *= sigmoidf_(bflo(ma.x)) * (1.0f + eb[0]); v0[1] *= sigmoidf_(bfhi(ma.x)) * (1.0f + eb[1]); v0[2] *= sigmoidf_(bflo(ma.y)) * (1.0f + eb[2]); v0[3] *= sigmoidf_(bfhi(ma.y)) * (1.0f + eb[3]);
                        v1[0] *= sigmoidf_(bflo(ma.z)) * (1.0f + eb[4]); v1[1] *= sigmoidf_(bfhi(ma.z)) * (1.0f + eb[5]); v1[2] *= sigmoidf_(bflo(ma.w)) * (1.0f + eb[6]); v1[3] *= sigmoidf_(bfhi(ma.w)) * (1.0f + eb[7]);
                        acc[ai][bj][m][0] = v0; acc[ai][bj][m][1] = v1;
                    } else {
                        v0[0] *= __builtin_amdgcn_rcpf(1.0f + eb[0]); v0[1] *= __builtin_amdgcn_rcpf(1.0f + eb[1]); v0[2] *= __builtin_amdgcn_rcpf(1.0f + eb[2]); v0[3] *= __builtin_amdgcn_rcpf(1.0f + eb[3]);
                        v1[0] *= __builtin_amdgcn_rcpf(1.0f + eb[4]); v1[1] *= __builtin_amdgcn_rcpf(1.0f + eb[5]); v1[2] *= __builtin_amdgcn_rcpf(1.0f + eb[6]); v1[3] *= __builtin_amdgcn_rcpf(1.0f + eb[7]);
                        u32x4 w; w.x = pk2(v0[0], v0[1]); w.y = pk2(v0[2], v0[3]); w.z = pk2(v1[0], v1[1]); w.w = pk2(v1[2], v1[3]);
                        *(u32x4*)(Y + row * DM + col) = w; } } }
        return !second;
    }
};
struct EpiOut {
    static constexpr bool PERM = false, AFTER_DRAIN = false, CHAIN = false, PREFETCH = true;
    const float* xl_src; float* xl_dst; const float* gate_lat;
    DI void prefetch(lds_t* lds, const pg8::Unit& u, int tid) const {
        const int wid = tid >> 6, lane = tid & 63;
#pragma unroll
        for (int it = 0; it < 4; ++it) { const int n = wid * 256 + it * 64 + lane, row = n >> 3, seg = n & 7;
            __builtin_amdgcn_global_load_lds((const unsigned*)(xl_src + (size_t)(u.pm * 256 + row) * DM + u.pn * 256 + seg * 32), (LAS unsigned*)(lds + 131072 + wid * 1024), 16, 0, 0); }
    }
    DI void operator()(const f32x4 (&acc)[2][2][4][2], const pg8::Unit& u, int wr, int wc, int fr, int fq) const {
        const int row0 = u.pm * 256 + wr * 64 + fr, col0 = u.pn * 256 + wc * 32 + 4 * fq;
        f32x4 gv[2][2];
#pragma unroll
        for (int bj = 0; bj < 2; ++bj)
#pragma unroll
            for (int n = 0; n < 2; ++n) gv[bj][n] = *(const f32x4*)(gate_lat + col0 + bj * 128 + n * 16);
#pragma unroll
        for (int ai = 0; ai < 2; ++ai)
#pragma unroll
            for (int m = 0; m < 4; ++m) { const size_t off = (size_t)(row0 + ai * 128 + m * 16) * DM + col0;
#pragma unroll
                for (int bj = 0; bj < 2; ++bj)
#pragma unroll
                    for (int n = 0; n < 2; ++n) { const f32x4 xo = *(const f32x4*)(xl_src + off + bj * 128 + n * 16);
                        *(f32x4*)(xl_dst + off + bj * 128 + n * 16) = xo + gv[bj][n] * acc[ai][bj][m][n]; } }
    }
};
template <int MODE> DI void ctx_patch(lds_t* L, const bf16_t* A0, const bf16_t* B0t, const bf16_t* A1, const bf16_t* B1t, const bf16_t* Ma, const bf16_t* Mb, bf16_t* Y,
                                      const float* xsrc, float* xdst, const float* gate) {
    const int tid = opaque_tid(), wid = tid >> 6, lane = tid & 63, g = lane >> 4, l15 = lane & 15;
    constexpr int NP = MODE == 0 ? 2 : 1;
    for (int patch = blockIdx.x; patch < 256; patch += gridDim.x) {
        const int pr = patch >> 5, pc = patch & 31;
        f32x4 acc[NP][2][2];
#pragma unroll
        for (int part = 0; part < NP; ++part) {
            const bf16_t* A = part ? A1 : A0; const bf16_t* Bt = part ? B1t : B0t;
            bf16x8 Af[2][4], Bf[2][4];
#pragma unroll
            for (int t2 = 0; t2 < 2; ++t2)
#pragma unroll
                for (int ks = 0; ks < 4; ++ks) { Af[t2][ks] = *(const bf16x8*)(A + (size_t)(32 * pr + 16 * t2 + l15) * 1024 + 128 * wid + 32 * ks + 8 * g);
                    Bf[t2][ks] = *(const bf16x8*)(Bt + (size_t)(32 * pc + 16 * t2 + l15) * 1024 + 128 * wid + 32 * ks + 8 * g); }
#pragma unroll
            for (int tm = 0; tm < 2; ++tm)
#pragma unroll
                for (int tn = 0; tn < 2; ++tn) { f32x4 a = (f32x4){0.f, 0.f, 0.f, 0.f};
#pragma unroll
                    for (int ks = 0; ks < 4; ++ks) a = MFMA16(Bf[tn][ks], Af[tm][ks], a);
                    acc[part][tm][tn] = a; }
        }
        __syncthreads();
        LAS f32x4* red = (LAS f32x4*)L;
#pragma unroll
        for (int part = 0; part < NP; ++part)
#pragma unroll
            for (int tm = 0; tm < 2; ++tm)
#pragma unroll
                for (int tn = 0; tn < 2; ++tn) red[((part * 8 + wid) * 4 + tm * 2 + tn) * 64 + lane] = acc[part][tm][tn];
        __syncthreads();
        if (tid < 256) {
            const int tile = tid >> 6, ln = tid & 63, tm = tile >> 1, tn = tile & 1;
            f32x4 s0 = (f32x4){0.f, 0.f, 0.f, 0.f}, s1 = s0;
#pragma unroll
            for (int w = 0; w < 8; ++w) { s0 += red[(w * 4 + tile) * 64 + ln]; if (MODE == 0) s1 += red[((8 + w) * 4 + tile) * 64 + ln]; }
            const size_t off = (size_t)(32 * pr + 16 * tm + (ln & 15)) * 1024 + 32 * pc + 16 * tn + 4 * (ln >> 4);
            if (MODE == 0) { const u32x2 ma = *(const u32x2*)(Ma + off), mb = *(const u32x2*)(Mb + off);
                const float y0 = sigmoidf_(bflo(ma.x)) * s0[0] + sigmoidf_(bflo(mb.x)) * s1[0], y1 = sigmoidf_(bfhi(ma.x)) * s0[1] + sigmoidf_(bfhi(mb.x)) * s1[1];
                const float y2 = sigmoidf_(bflo(ma.y)) * s0[2] + sigmoidf_(bflo(mb.y)) * s1[2], y3 = sigmoidf_(bfhi(ma.y)) * s0[3] + sigmoidf_(bfhi(mb.y)) * s1[3];
                u32x2 w; w.x = pk2(y0, y1); w.y = pk2(y2, y3); *(u32x2*)(Y + off) = w; }
            else { const f32x4 xo = *(const f32x4*)(xsrc + off), gv = *(const f32x4*)(gate + 32 * pc + 16 * tn + 4 * (ln >> 4)); *(f32x4*)(xdst + off) = xo + gv * s0; }
        }
        __syncthreads();
    }
}

DI void phase_ada(kparams_t p, lds_t* L, float* mod) {
    const int tid = opaque_tid(), wid = tid >> 6, lane = tid & 63;
    LAS float* sc = (LAS float*)L; LAS float* red = sc + 3072;
    for (int i = tid; i < 3072; i += 512) { const int v = i >> 10, k = i & 1023; const float c = (v < 2) ? p->c[v * 1024 + k] : p->c_ctx[k]; sc[i] = siluf_(c); }
    __syncthreads();
    for (int it = blockIdx.x; it < DEPTH * 48; it += gridDim.x) {
        const int l = it / 48, cgp = it % 48, n = cgp * 64 + lane;
        const float* W = p->w_ada + (size_t)l * 1024 * 3072 + n;
        float a0 = 0.f, a1 = 0.f, a2 = 0.f;
#pragma unroll 8
        for (int kk = 0; kk < 128; ++kk) { const int k = wid * 128 + kk; const float w = W[(size_t)k * 3072]; a0 += sc[k] * w; a1 += sc[1024 + k] * w; a2 += sc[2048 + k] * w; }
        red[(wid * 3 + 0) * 64 + lane] = a0; red[(wid * 3 + 1) * 64 + lane] = a1; red[(wid * 3 + 2) * 64 + lane] = a2;
        __syncthreads();
        if (tid < 192) { const int v = tid >> 6, ln = tid & 63; float s = 0.f;
#pragma unroll
            for (int w = 0; w < 8; ++w) s += red[(w * 3 + v) * 64 + ln];
            const int nn = cgp * 64 + ln; mod[(l * 3 + v) * 3072 + nn] = s + p->b_ada[l * 3072 + nn]; }
        __syncthreads();
    }
}

DI void transpose_item(const float* W, int ldw, int k0, int c0, bf16_t* WT, int n0, LAS float* scr, int lane) {
#pragma unroll 8
    for (int i = 0; i < 32; ++i) { const int kk = 2 * i + (lane >> 5); scr[kk * 33 + (lane & 31)] = W[(size_t)(k0 + kk) * ldw + c0 + (lane & 31)]; }
    asm volatile("s_waitcnt lgkmcnt(0)" ::: "memory");
    const int c = lane & 7;
#pragma unroll
    for (int j = 0; j < 4; ++j) { const int n = (lane >> 3) + 8 * j; const LAS float* s = scr + (8 * c) * 33 + n;
        u32x4 o; o.x = pk2(s[0 * 33], s[1 * 33]); o.y = pk2(s[2 * 33], s[3 * 33]); o.z = pk2(s[4 * 33], s[5 * 33]); o.w = pk2(s[6 * 33], s[7 * 33]);
        *(u32x4*)(WT + (size_t)(n0 + n) * 1024 + k0 + 8 * c) = o; }
    asm volatile("s_waitcnt lgkmcnt(0)" ::: "memory");
}
DI void phase_wconv(kparams_t p, lds_t* L, int l, bf16_t* BtIn, bf16_t* BtA, bf16_t* BtB, bf16_t* BtO, float* bias2) {
    const int tid = opaque_tid(), wid = tid >> 6, lane = tid & 63;
    LAS float* scr = (LAS float*)(L + wid * 8448);
    const float* Win = p->w_in + (size_t)l * 1024 * NIN_W;
    const int gw = blockIdx.x * 8 + wid, NGW = gridDim.x * 8;
    constexpr int I_IN = 384 * 16, I_SQ = 32 * 16;
    for (int it = gw; it < I_IN + 3 * I_SQ; it += NGW) {
        if (it < I_IN) { const int nb = it >> 4, kb = it & 15, n0 = 32 * nb; transpose_item(Win, NIN_W, 64 * kb, n0 < 5120 ? n0 : n0 + 16, BtIn, n0, scr, lane); }
        else { int r = it - I_IN; const int m = r / I_SQ; r -= m * I_SQ; const int nb = r >> 4, kb = r & 15;
            const float* W = (m == 0 ? p->w_a : m == 1 ? p->w_b : p->w_out) + (size_t)l * 1024 * 1024; bf16_t* WT = m == 0 ? BtA : m == 1 ? BtB : BtO;
            transpose_item(W, 1024, 64 * kb, 32 * nb, WT, 32 * nb, scr, lane); }
    }
    const int gt = blockIdx.x * 512 + tid, NGT = gridDim.x * 512;
    for (int i = gt; i < 256 * 1024; i += NGT) { const int n = 12288 + (i >> 10), k = i & 1023; const float v = (n < 12304) ? Win[(size_t)k * NIN_W + 5120 + (n - 12288)] : 0.f; BtIn[(size_t)n * 1024 + k] = f2bf(v); }
    const float* bi = p->b_in + (size_t)l * NIN_W;
    for (int i = gt; i < NPAD; i += NGT) bias2[i] = i < 5120 ? bi[i] : i < 12288 ? bi[i + 16] : i < 12304 ? bi[5120 + i - 12288] : 0.f;
}

DI void phase_norm(kparams_t p, int l, int b, const float* xl, const float* xc, const float* mod, bf16_t* hA) {
    const int tid_ = opaque_tid(), wid = tid_ >> 6, lane = tid_ & 63;
    const float* gn = p->g_norm + l * 1024;
    for (int r = blockIdx.x * 8 + wid; r < MB; r += gridDim.x * 8) {
        const float* src = r < 256 ? xc + (size_t)r * DM : xl + (size_t)(r - 256) * DM;
        const float* md = mod + (l * 3 + (r < 256 ? 2 : b)) * 3072;
        f32x4 v[4]; float s = 0.f;
#pragma unroll
        for (int j = 0; j < 4; ++j) { v[j] = *(const f32x4*)(src + 4 * lane + 256 * j); s += v[j][0] * v[j][0] + v[j][1] * v[j][1] + v[j][2] * v[j][2] + v[j][3] * v[j][3]; }
        const float rs = rsqrtf(wave_sum(s) * (1.f / DM) + EPS);
#pragma unroll
        for (int j = 0; j < 4; ++j) { const int i = 4 * lane + 256 * j;
            const f32x4 g = *(const f32x4*)(gn + i), sh = *(const f32x4*)(md + i), scl = *(const f32x4*)(md + 1024 + i);
            const f32x4 y = (v[j] * rs * g) * (scl + 1.0f) + sh;
            u32x2 w; w.x = pk2(y[0], y[1]); w.y = pk2(y[2], y[3]); *(u32x2*)(hA + (size_t)r * DM + i) = w; }
    }
}

DI void phase_conv(kparams_t p, int l, const bf16_t* P, bf16_t* QKc) {
    const int tid = opaque_tid(), cgp = tid & 255, sub = tid >> 8, c0 = 8 * cgp;
    const float* wc = p->w_conv + (size_t)l * 9 * 2048 + c0; const float* bc = p->b_conv + l * 2048 + c0;
    float w[9][8], bias[8];
#pragma unroll
    for (int a = 0; a < 9; ++a) { const f32x4 lo = *(const f32x4*)(wc + a * 2048), hi = *(const f32x4*)(wc + a * 2048 + 4);
#pragma unroll
        for (int i = 0; i < 4; ++i) { w[a][i] = lo[i]; w[a][4 + i] = hi[i]; } }
    { const f32x4 lo = *(const f32x4*)bc, hi = *(const f32x4*)(bc + 4);
#pragma unroll
      for (int i = 0; i < 4; ++i) { bias[i] = lo[i]; bias[4 + i] = hi[i]; } }
    const float oscale = c0 >= 1024 ? 0.0625f : 1.0f;
    for (int rp = blockIdx.x; rp < MB / 2; rp += gridDim.x) {
        const int r = 2 * rp + sub;
        float acc[8];
#pragma unroll
        for (int i = 0; i < 8; ++i) acc[i] = bias[i];
        if (r >= 256) {
            const int t = r - 256, y = t >> 6, x = t & 63;
            u32x4 uu[9]; float wm[9];
#pragma unroll
            for (int a = 0; a < 3; ++a)
#pragma unroll
                for (int bb = 0; bb < 3; ++bb) { const int yy = y + a - 1, xx = x + bb - 1; const bool ok = yy >= 0 && yy < 256 && xx >= 0 && xx < 64;
                    const int yc = min(max(yy, 0), 255), xc = min(max(xx, 0), 63);
                    uu[a * 3 + bb] = *(const u32x4*)(P + PG(c0) + (size_t)(256 + yc * 64 + xc) * 1024 + (c0 & 1023)); wm[a * 3 + bb] = ok ? 1.f : 0.f; }
#pragma unroll
            for (int k = 0; k < 9; ++k) { const u32x4 u = uu[k]; const float m = wm[k];
                acc[0] += (w[k][0] * m) * bflo(u.x); acc[1] += (w[k][1] * m) * bfhi(u.x); acc[2] += (w[k][2] * m) * bflo(u.y); acc[3] += (w[k][3] * m) * bfhi(u.y);
                acc[4] += (w[k][4] * m) * bflo(u.z); acc[5] += (w[k][5] * m) * bfhi(u.z); acc[6] += (w[k][6] * m) * bflo(u.w); acc[7] += (w[k][7] * m) * bfhi(u.w); }
        } else {
#pragma unroll
            for (int bb = 0; bb < 3; ++bb) { const int tt = r + bb - 1;
                if (tt >= 0 && tt < 256) { const u32x4 u = *(const u32x4*)(P + PG(c0) + (size_t)tt * 1024 + (c0 & 1023));
                    acc[0] += w[3 + bb][0] * bflo(u.x); acc[1] += w[3 + bb][1] * bfhi(u.x); acc[2] += w[3 + bb][2] * bflo(u.y); acc[3] += w[3 + bb][3] * bfhi(u.y);
                    acc[4] += w[3 + bb][4] * bflo(u.z); acc[5] += w[3 + bb][5] * bfhi(u.z); acc[6] += w[3 + bb][6] * bflo(u.w); acc[7] += w[3 + bb][7] * bfhi(u.w); } }
        }
#pragma unroll
        for (int i = 0; i < 8; ++i) acc[i] = siluf_(acc[i]) * oscale;
        u32x4 o; o.x = pk2(acc[0], acc[1]); o.y = pk2(acc[2], acc[3]); o.z = pk2(acc[4], acc[5]); o.w = pk2(acc[6], acc[7]);
        *(u32x4*)(QKc + (size_t)r * 2048 + c0) = o;
    }
}

DI void phase_post(kparams_t p, int l, bf16_t* P, const bf16_t* HF, const bf16_t* HB) {
    const int tid_ = opaque_tid(), wid = tid_ >> 6, lane = tid_ & 63;
    const float* ga = p->g_head_a + l * 1024; const float* gb = p->g_head_b + l * 1024;
    for (int r = blockIdx.x * 8 + wid; r < MB; r += gridDim.x * 8) {
        bf16_t* pr = P + (size_t)r * 1024;
        u32x2 ahf[4], ahb[4], aog[4], azz[4], bhf[4], bhb[4], bzz[4];
#pragma unroll
        for (int h = 0; h < 4; ++h) { const int c4 = 256 * h + 4 * lane;
            ahf[h] = *(const u32x2*)(HF + (size_t)r * 1024 + c4); ahb[h] = *(const u32x2*)(HB + (size_t)r * 1024 + c4); aog[h] = *(const u32x2*)(pr + PG(PC_O) + c4); azz[h] = *(const u32x2*)(pr + PG(PC_ZA) + c4);
            bhf[h] = *(const u32x2*)(pr + PG(PC_OF) + c4); bhb[h] = *(const u32x2*)(pr + PG(PC_OB) + c4); bzz[h] = *(const u32x2*)(pr + PG(PC_ZB) + c4); }
#pragma unroll
        for (int h = 0; h < 4; ++h) { const int c4 = 256 * h + 4 * lane;
            const u32x2 hf = ahf[h], hb = ahb[h], og = aog[h], zz = azz[h];
            float hh[4] = {(bflo(hf.x) + bflo(hb.x)) * sigmoidf_(bflo(og.x)), (bfhi(hf.x) + bfhi(hb.x)) * sigmoidf_(bfhi(og.x)), (bflo(hf.y) + bflo(hb.y)) * sigmoidf_(bflo(og.y)), (bfhi(hf.y) + bfhi(hb.y)) * sigmoidf_(bfhi(og.y))};
            const float rs = rsqrtf(wave_sum(hh[0] * hh[0] + hh[1] * hh[1] + hh[2] * hh[2] + hh[3] * hh[3]) * (1.f / 256.f) + EPS);
            const f32x4 g = *(const f32x4*)(ga + c4);
            const float z[4] = {bflo(zz.x), bfhi(zz.x), bflo(zz.y), bfhi(zz.y)};
            float y[4];
#pragma unroll
            for (int i = 0; i < 4; ++i) y[i] = hh[i] * rs * g[i] * siluf_(z[i]);
            u32x2 w; w.x = pk2(y[0], y[1]); w.y = pk2(y[2], y[3]); *(u32x2*)(pr + PG(PC_O) + c4) = w; }
#pragma unroll
        for (int hp = 0; hp < 4; ++hp) { const int c4 = 256 * hp + 4 * lane;
            const u32x2 hf = bhf[hp], hb = bhb[hp], zz = bzz[hp];
            float hh[4] = {bflo(hf.x) + bflo(hb.x), bfhi(hf.x) + bfhi(hb.x), bflo(hf.y) + bflo(hb.y), bfhi(hf.y) + bfhi(hb.y)};
            float s = hh[0] * hh[0] + hh[1] * hh[1] + hh[2] * hh[2] + hh[3] * hh[3];
#pragma unroll
            for (int o = 1; o < 32; o <<= 1) s += shx(s, o);
            const float rs = rsqrtf(s * (1.f / 128.f) + EPS);
            const f32x4 g = *(const f32x4*)(gb + c4);
            const float z[4] = {bflo(zz.x), bfhi(zz.x), bflo(zz.y), bfhi(zz.y)};
            float y[4];
#pragma unroll
            for (int i = 0; i < 4; ++i) y[i] = hh[i] * rs * g[i] * siluf_(z[i]);
            u32x2 w; w.x = pk2(y[0], y[1]); w.y = pk2(y[2], y[3]); *(u32x2*)(pr + PG(PC_ZB) + c4) = w; }
    }
}

DI void phase_final(kparams_t p, float* out) {
    const int tid_ = opaque_tid(), wid = tid_ >> 6, lane = tid_ & 63;
    for (int r = blockIdx.x * 8 + wid; r < NB * SEQ; r += gridDim.x * 8) {
        float* row = out + (size_t)r * DM; f32x4 v[4]; float s = 0.f;
#pragma unroll
        for (int j = 0; j < 4; ++j) { v[j] = *(const f32x4*)(row + 4 * lane + 256 * j); s += v[j][0] * v[j][0] + v[j][1] * v[j][1] + v[j][2] * v[j][2] + v[j][3] * v[j][3]; }
        const float rs = rsqrtf(wave_sum(s) * (1.f / DM) + EPS);
#pragma unroll
        for (int j = 0; j < 4; ++j) { const f32x4 g = *(const f32x4*)(p->g_final + 4 * lane + 256 * j); *(f32x4*)(row + 4 * lane + 256 * j) = v[j] * rs * g; }
    }
}

DI int sc_order(int d, int j) { return d == 0 ? j : (j == 0 ? 0 : NSC - j); }
constexpr int KST = 528;
constexpr int ML_BUFK = 0, ML_BUFV = 64 * KST, ML_F0 = 2 * 64 * KST, ML_F1 = ML_F0 + 1024, ML_F2 = ML_F1 + 1024, ML_F3 = ML_F2 + 1024;

template <int MODE> DI void mlstm_scalars(const float* G, int row0, int h, int d, float m_in, lds_t* L, float& Bout, float& mout) {
    const int lane = opaque_tid() & 63;
    LAS float* F0 = (LAS float*)(L + ML_F0); LAS float* F1 = (LAS float*)(L + ML_F1); LAS float* F2 = (LAS float*)(L + ML_F2);
    float li[4], bb[4]; int rr[4]; float run = 0.f;
#pragma unroll
    for (int i = 0; i < 4; ++i) { const int pp = 4 * lane + i; rr[i] = d ? 255 - pp : pp; const float* gr = G + (size_t)(row0 + rr[i]) * 16;
        li[i] = gr[(2 * d) * 4 + h]; run += logsigmoidf_(gr[(2 * d + 1) * 4 + h]); bb[i] = run; }
    float incl = run;
#pragma unroll
    for (int o = 1; o < 64; o <<= 1) { const float v = shup(incl, o); if (lane >= o) incl += v; }
    const float excl = incl - run; const float B = rdlane63(incl);
#pragma unroll
    for (int i = 0; i < 4; ++i) bb[i] += excl;
    if (MODE == 0) {
        float ws[4], mx = -3.0e38f;
#pragma unroll
        for (int i = 0; i < 4; ++i) { ws[i] = B - bb[i] + li[i]; mx = fmaxf(mx, ws[i]); }
        mx = wave_max(mx);
#pragma unroll
        for (int i = 0; i < 4; ++i) F0[rr[i]] = __expf(ws[i] - mx);
        Bout = B; mout = mx;
    } else {
        float u[4], pm[4], mx = -3.0e38f;
#pragma unroll
        for (int i = 0; i < 4; ++i) { u[i] = li[i] - bb[i]; mx = fmaxf(mx, u[i]); pm[i] = mx; }
        float inc = mx;
#pragma unroll
        for (int o = 1; o < 64; o <<= 1) { const float v = shup(inc, o); if (lane >= o) inc = fmaxf(inc, v); }
        float ex = shup(inc, 1); if (lane == 0) ex = -3.0e38f;
#pragma unroll
        for (int i = 0; i < 4; ++i) { F0[rr[i]] = u[i]; F1[rr[i]] = fmaxf(m_in, fmaxf(ex, pm[i])); F2[rr[i]] = bb[i]; }
        Bout = B; mout = 0.f;
    }
}

DI void mlstm_passA(int item, lds_t* L, const bf16_t* P, const bf16_t* QKc, const float* G, bf16_t* STA, float* NST, float* SCA) {
    const int tid = opaque_tid(), wid = tid >> 6, lane = tid & 63, g = lane >> 4, q4 = (lane >> 2) & 3, p4 = lane & 3, l15 = lane & 15;
    const int j = item % NSC, hd = item / NSC, d = hd & 1, h = hd >> 1, scan = hd, o = sc_order(d, j), row0 = 256 * j;
    constexpr int A_PAIR = 2 * 64 * KST, A_SCAL = 2 * A_PAIR;
    lds_t* LS = L + (A_SCAL - ML_F0);
    u32x4 pk[4], pv[4];
#define MA_LOAD(sb_) do { _Pragma("unroll") for (int it = 0; it < 4; ++it) { const int c = tid + 512 * it, r = c >> 5, c16 = c & 31; const size_t grow = (size_t)(row0 + 64 * (sb_) + r); \
        pk[it] = *(const u32x4*)(QKc + grow * 2048 + 1024 + 256 * h + 8 * c16); pv[it] = *(const u32x4*)(P + PG(PC_V) + grow * 1024 + 256 * h + 8 * c16); } } while (0)
    MA_LOAD(0);
    __syncthreads();
    if (wid == 0) { float Bv, mv; mlstm_scalars<0>(G, row0, h, d, 0.f, LS, Bv, mv); if (lane == 0) { SCA[scan * NSC + o] = Bv; SCA[520 + scan * NSC + o] = mv; } }
    __syncthreads();
    LAS float* WSE = (LAS float*)(LS + ML_F0);
    f32x4 acc[2][16];
#pragma unroll
    for (int a = 0; a < 2; ++a)
#pragma unroll
        for (int n = 0; n < 16; ++n) acc[a][n] = (f32x4){0.f, 0.f, 0.f, 0.f};
    f32x4 nacc[2] = {(f32x4){0.f, 0.f, 0.f, 0.f}, (f32x4){0.f, 0.f, 0.f, 0.f}};
    bf16x8 ones;
#pragma unroll
    for (int i = 0; i < 8; ++i) ones[i] = (short)0x3F80;
    for (int sb = 0; sb < 4; ++sb) {
        const int pb = (sb & 1) * A_PAIR;
#pragma unroll
        for (int it = 0; it < 4; ++it) { const int c = tid + 512 * it, r = c >> 5, c16 = c & 31;
            const u32x4 kv = pk[it]; const float w = WSE[64 * sb + r];
            u32x4 ko; ko.x = pk2(bflo(kv.x) * w, bfhi(kv.x) * w); ko.y = pk2(bflo(kv.y) * w, bfhi(kv.y) * w); ko.z = pk2(bflo(kv.z) * w, bfhi(kv.z) * w); ko.w = pk2(bflo(kv.w) * w, bfhi(kv.w) * w);
            *(LAS u32x4*)(L + pb + ML_BUFK + r * KST + 16 * c16) = ko; *(LAS u32x4*)(L + pb + ML_BUFV + r * KST + 16 * c16) = pv[it]; }
        __syncthreads();
        if (sb < 3) MA_LOAD(sb + 1);
#pragma unroll
        for (int ks = 0; ks < 2; ++ks) {
            lds_t* ka = L + pb + ML_BUFK + (32 * ks + 8 * g + q4) * KST + (32 * wid + 4 * p4) * 2;
            const bf16x8 A0 = mk8(trrd(ka), trrd(ka + 4 * KST)), A1 = mk8(trrd(ka + 32), trrd(ka + 32 + 4 * KST));
            nacc[0] = MFMA16(A0, ones, nacc[0]); nacc[1] = MFMA16(A1, ones, nacc[1]);
            lds_t* va = L + pb + ML_BUFV + (32 * ks + 8 * g + q4) * KST + (4 * p4) * 2;
#pragma unroll
            for (int n = 0; n < 16; ++n) { const bf16x8 Bf = mk8(trrd(va + 32 * n), trrd(va + 32 * n + 4 * KST));
                acc[0][n] = MFMA16(A0, Bf, acc[0][n]); acc[1][n] = MFMA16(A1, Bf, acc[1][n]); }
        }
    }
#undef MA_LOAD
    bf16_t* slot = STA + (size_t)(scan * NSC + o) * 65536;
#pragma unroll
    for (int a = 0; a < 2; ++a)
#pragma unroll
        for (int n = 0; n < 16; ++n) { u32x2 w; w.x = pk2(acc[a][n][0], acc[a][n][1]); w.y = pk2(acc[a][n][2], acc[a][n][3]);
            *(u32x2*)(slot + (size_t)(16 * n + l15) * 256 + 32 * wid + 16 * a + 4 * g) = w; }
    if (l15 == 0) {
#pragma unroll
        for (int a = 0; a < 2; ++a) *(f32x4*)(NST + (size_t)(scan * NSC + o) * 256 + 32 * wid + 16 * a + 4 * g) = nacc[a]; }
}

DI void mlstm_passB(bf16_t* STA, float* NST, float* SCA) {
    const int gt = blockIdx.x * 512 + opaque_tid(), NGT = gridDim.x * 512;
    for (int idx = gt; idx < 8 * 8192 + 8 * 64; idx += NGT) {
        const bool isn = idx >= 8 * 8192; const int r = isn ? idx - 8 * 8192 : idx; const int scan = isn ? r >> 6 : r >> 13, off = isn ? (r & 63) * 4 : (r & 8191) * 8;
        float run[8], mrun = 0.f;
#pragma unroll
        for (int i = 0; i < 8; ++i) run[i] = 0.f;
        u32x4 nlv[8]; f32x4 nnv[8]; float nBs[8], nmls[8];
#define MB_LOAD(o0_) do { _Pragma("unroll") for (int k = 0; k < 8; ++k) { if (isn) nnv[k] = *(const f32x4*)(NST + (size_t)(scan * NSC + (o0_) + k) * 256 + off); else nlv[k] = *(const u32x4*)(STA + (size_t)(scan * NSC + (o0_) + k) * 65536 + off); \
            nBs[k] = SCA[scan * NSC + (o0_) + k]; nmls[k] = SCA[520 + scan * NSC + (o0_) + k]; } } while (0)
        MB_LOAD(0);
        for (int o0 = 0; o0 < 64; o0 += 8) {
            u32x4 lv[8]; f32x4 nv[8]; float Bs[8], mls[8];
#pragma unroll
            for (int k = 0; k < 8; ++k) { lv[k] = nlv[k]; nv[k] = nnv[k]; Bs[k] = nBs[k]; mls[k] = nmls[k]; }
            if (o0 < 56) MB_LOAD(o0 + 8);
#pragma unroll
            for (int k = 0; k < 8; ++k) { const int o = o0 + k; const float Bv = Bs[k], ml = mls[k];
                const float mn = fmaxf(Bv + mrun, ml), dec = __expf(Bv + mrun - mn), sc = __expf(ml - mn); mrun = mn;
                if (isn) {
#pragma unroll
                    for (int i = 0; i < 4; ++i) run[i] = dec * run[i] + sc * nv[k][i];
                    *(f32x4*)(NST + (size_t)(scan * NSC + o) * 256 + off) = (f32x4){run[0], run[1], run[2], run[3]};
                    if (off == 0) SCA[1040 + scan * NSC + o] = mn;
                } else {
                    run[0] = dec * run[0] + sc * bflo(lv[k].x); run[1] = dec * run[1] + sc * bfhi(lv[k].x); run[2] = dec * run[2] + sc * bflo(lv[k].y); run[3] = dec * run[3] + sc * bfhi(lv[k].y);
                    run[4] = dec * run[4] + sc * bflo(lv[k].z); run[5] = dec * run[5] + sc * bfhi(lv[k].z); run[6] = dec * run[6] + sc * bflo(lv[k].w); run[7] = dec * run[7] + sc * bfhi(lv[k].w);
                    u32x4 w; w.x = pk2(run[0], run[1]); w.y = pk2(run[2], run[3]); w.z = pk2(run[4], run[5]); w.w = pk2(run[6], run[7]);
                    *(u32x4*)(STA + (size_t)(scan * NSC + o) * 65536 + off) = w; } }
        }
#undef MB_LOAD
    }
}

constexpr int MC_PAIR = 2 * 64 * KST, MC_SCAL = 2 * MC_PAIR;
DI void mlstm_passC(int item, lds_t* L, const bf16_t* P, bf16_t* HF, bf16_t* HB, const bf16_t* QKc, const float* G, const bf16_t* STA, const float* NST, const float* SCA) {
    const int tid = opaque_tid(), wid = tid >> 6, lane = tid & 63, g = lane >> 4, q4 = (lane >> 2) & 3, p4 = lane & 3, l15 = lane & 15;
    const int qb = item & 1, it2 = item >> 1, j = it2 % NSC, hd = it2 / NSC, d = hd & 1, h = hd >> 1, scan = hd, o = sc_order(d, j), row0 = 256 * j;
    const float m_in = o > 0 ? SCA[1040 + scan * NSC + o - 1] : 0.f;
    lds_t* LS = L + (MC_SCAL - ML_F0);
    const int trow = 128 * qb + 16 * wid + l15;
    const int kb_lo = d ? 2 * qb : 0, kb_hi = d ? 3 : 2 * qb + 1;
    const bf16_t* sin = STA + (size_t)(scan * NSC + (o > 0 ? o - 1 : 0)) * 65536;
    u32x4 pk[4], pv[4];
#define MC_LOADKV(kb_) do { _Pragma("unroll") for (int it = 0; it < 4; ++it) { const int c = tid + 512 * it, r = c >> 5, c16 = c & 31; const size_t grow = (size_t)(row0 + 64 * (kb_) + r); \
        pk[it] = *(const u32x4*)(QKc + grow * 2048 + 1024 + 256 * h + 8 * c16); pv[it] = *(const u32x4*)(P + PG(PC_V) + grow * 1024 + 256 * h + 8 * c16); } } while (0)
#define MC_LOADC(ep_) do { _Pragma("unroll") for (int it = 0; it < 4; ++it) { const int c = tid + 512 * it, r = c >> 5, c16 = c & 31; \
        pk[it] = *(const u32x4*)(sin + (size_t)(128 * (ep_) + r) * 256 + 8 * c16); pv[it] = *(const u32x4*)(sin + (size_t)(128 * (ep_) + 64 + r) * 256 + 8 * c16); } } while (0)
#define MC_STOREK(pb_) do { _Pragma("unroll") for (int it = 0; it < 4; ++it) { const int c = tid + 512 * it, r = c >> 5, c16 = c & 31; *(LAS u32x4*)(L + (pb_) + ML_BUFK + r * KST + 16 * c16) = pk[it]; } } while (0)
#define MC_STOREV(pb_) do { _Pragma("unroll") for (int it = 0; it < 4; ++it) { const int c = tid + 512 * it, r = c >> 5, c16 = c & 31; *(LAS u32x4*)(L + (pb_) + ML_BUFV + r * KST + 16 * c16) = pv[it]; } } while (0)
    bf16x8 Qf[8];
    { const bf16_t* qp = QKc + (size_t)(row0 + trow) * 2048 + 256 * h + 8 * g;
#pragma unroll
      for (int ks = 0; ks < 8; ++ks) Qf[ks] = *(const bf16x8*)(qp + 32 * ks); }
    if (o > 0) MC_LOADC(0); else MC_LOADKV(kb_lo);
    __syncthreads();
    if (wid == 0) { float Bv, mv; mlstm_scalars<1>(G, row0, h, d, m_in, LS, Bv, mv); }
    LAS float* NIN = (LAS float*)(LS + ML_F3);
    if (tid >= 256) NIN[tid - 256] = o > 0 ? NST[(size_t)(scan * NSC + o - 1) * 256 + tid - 256] : 0.f;
    __syncthreads();
    LAS float* U = (LAS float*)(LS + ML_F0); LAS float* MM = (LAS float*)(LS + ML_F1); LAS float* BBv = (LAS float*)(LS + ML_F2);
    const float Mt = MM[trow], at = __expf(m_in - Mt);
    f32x4 acc[16];
#pragma unroll
    for (int n = 0; n < 16; ++n) acc[n] = (f32x4){0.f, 0.f, 0.f, 0.f};
    if (o > 0) {
#pragma unroll
        for (int ep = 0; ep < 2; ++ep) {
            const int pb = ep * MC_PAIR;
            MC_STOREK(pb); MC_STOREV(pb);
            __syncthreads();
            if (ep < 1) MC_LOADC(1); else MC_LOADKV(kb_lo);
#pragma unroll
            for (int hh = 0; hh < 2; ++hh)
#pragma unroll
                for (int nt = 0; nt < 4; ++nt)
#pragma unroll
                    for (int ks = 0; ks < 8; ++ks) { const bf16x8 Af = *(LAS bf16x8*)(L + pb + (hh ? ML_BUFV : ML_BUFK) + (16 * nt + l15) * KST + (32 * ks + 8 * g) * 2);
                        acc[8 * ep + 4 * hh + nt] = MFMA16(Af, Qf[ks], acc[8 * ep + 4 * hh + nt]); }
        }
#pragma unroll
        for (int n = 0; n < 16; ++n) acc[n] *= at;
    }
    float den = 0.f;
    const int wmin = 128 * qb + 16 * wid, wmax = wmin + 15;
    for (int kb = kb_lo; kb <= kb_hi; ++kb) {
        const int pb = ((kb - kb_lo) & 1) * MC_PAIR;
        MC_STOREK(pb); MC_STOREV(pb);
        __syncthreads();
        if (kb < kb_hi) MC_LOADKV(kb + 1);
#pragma unroll
        for (int ks2 = 0; ks2 < 2; ++ks2) {
            const int s0 = 64 * kb + 32 * ks2;
            const bool skip = d ? (s0 + 31 < wmin) : (s0 > wmax);
            if (!skip) {
                f32x4 wv[2];
#pragma unroll
                for (int tt = 0; tt < 2; ++tt) {
                    wv[tt] = (f32x4){0.f, 0.f, 0.f, 0.f};
                    const bool tskip = d ? (s0 + 16 * tt + 15 < wmin) : (s0 + 16 * tt > wmax);
                    if (!tskip) { f32x4 sa = (f32x4){0.f, 0.f, 0.f, 0.f};
#pragma unroll
                        for (int ks = 0; ks < 8; ++ks) { const bf16x8 Af = *(LAS bf16x8*)(L + pb + ML_BUFK + (32 * ks2 + 16 * tt + l15) * KST + (32 * ks + 8 * g) * 2); sa = MFMA16(Af, Qf[ks], sa); }
                        const int sr = s0 + 16 * tt + 4 * g; const f32x4 us = *(LAS f32x4*)(U + sr);
#pragma unroll
                        for (int jj = 0; jj < 4; ++jj) { const bool ok = d ? (sr + jj >= trow) : (sr + jj <= trow); const float w = ok ? sa[jj] * __expf(us[jj] - Mt) : 0.f; den += w; wv[tt][jj] = w; } } }
                const bf16x8 Pf = pack8(wv[0], wv[1]);
                lds_t* va = L + pb + ML_BUFV + (32 * ks2 + 4 * g + q4) * KST + (4 * p4) * 2;
#pragma unroll
                for (int n = 0; n < 16; ++n) { const bf16x8 Vf = mk8(trrd(va + 32 * n), trrd(va + 32 * n + 16 * KST)); acc[n] = MFMA16(Vf, Pf, acc[n]); }
            }
        }
    }
#undef MC_LOADKV
#undef MC_LOADC
#undef MC_STOREK
#undef MC_STOREV
    den += shx(den, 16); den += shx(den, 32);
    float qn = 0.f;
#pragma unroll
    for (int ks = 0; ks < 8; ++ks) { const f32x4 n0 = *(LAS f32x4*)(NIN + 32 * ks + 8 * g), n1 = *(LAS f32x4*)(NIN + 32 * ks + 8 * g + 4); const u32x4 qw = __builtin_bit_cast(u32x4, Qf[ks]);
        qn += bflo(qw.x) * n0[0] + bfhi(qw.x) * n0[1] + bflo(qw.y) * n0[2] + bfhi(qw.y) * n0[3] + bflo(qw.z) * n1[0] + bfhi(qw.z) * n1[1] + bflo(qw.w) * n1[2] + bfhi(qw.w) * n1[3]; }
    qn += shx(qn, 16); qn += shx(qn, 32);
    den += __expf(m_in - Mt) * qn;
    const float inv = 1.0f / fmaxf(fabsf(den), __expf(-(BBv[trow] + Mt)));
    bf16_t* hp = (d ? HB : HF) + (size_t)(row0 + trow) * 1024 + 256 * h + 4 * g;
#pragma unroll
    for (int n = 0; n < 16; ++n) { u32x2 w; w.x = pk2(acc[n][0] * inv, acc[n][1] * inv); w.y = pk2(acc[n][2] * inv, acc[n][3] * inv); *(u32x2*)(hp + 16 * n) = w; }
}

constexpr int HST = 272;
typedef float f32x2v __attribute__((ext_vector_type(2)));
DI f32x2v mkf2(float a, float b) { f32x2v r = {a, b}; return r; }
constexpr int HG_PT = 0, HG_DEC = 2048, HG_EM = 2560, HG_EL = 3072, HG_QT = 3584, HG_KT = HG_QT + 32 * HST, HG_VV = HG_KT + 32 * HST;
constexpr int HG_SZ = HG_VV + 32 * HST;
template <bool OUT> DI void hgrn_item(int pair, lds_t* L0, bf16_t* P, bf16_t* STB, float* GSUM, const float* lbs) {
    const int tid = opaque_tid(), half = tid >> 8, lt = tid & 255, wl = lt >> 6, lane = tid & 63, g = lane >> 4, q4 = (lane >> 2) & 3, p4 = lane & 3, l15 = lane & 15;
    const int item = 2 * pair + half;
    lds_t* L = L0 + half * HG_SZ;
    const int j = item % NSC, hd = item / NSC, d = hd & 1, hb = hd >> 1, scan = hd, o = sc_order(d, j), row0 = 256 * j;
    const int cp = lane, c0 = 2 * cp, part = wl;
    const size_t fcol = PG(d ? PC_FB : PC_FF) + 128 * hb;
    const size_t ocol = PG(d ? PC_OB : PC_OF) + 128 * hb;
    const float lb0 = lbs[128 * hb + c0], lb1 = lbs[128 * hb + c0 + 1], om0 = 1.0f - lb0, om1 = 1.0f - lb1;
    LAS float* PT = (LAS float*)(L + HG_PT); LAS float* DEC = (LAS float*)(L + HG_DEC); LAS float* EM = (LAS float*)(L + HG_EM); LAS float* EL = (LAS float*)(L + HG_EL);
    f32x4 Sacc[2][8];
#pragma unroll
    for (int es = 0; es < 2; ++es) {
        if (OUT && o > 0) { const bf16_t* sin = STB + (size_t)(scan * NSC + o - 1) * 16384 + (size_t)(16 * (2 * wl + es) + l15) * 128 + 4 * g;
#pragma unroll
            for (int ct = 0; ct < 8; ++ct) { const u32x2 w = *(const u32x2*)(sin + 16 * ct); Sacc[es][ct] = (f32x4){bflo(w.x), bfhi(w.x), bflo(w.y), bfhi(w.y)}; }
        } else {
#pragma unroll
            for (int ct = 0; ct < 8; ++ct) Sacc[es][ct] = (f32x4){0.f, 0.f, 0.f, 0.f};
        }
    }
    float gsum0 = 0.f, gsum1 = 0.f;
    unsigned rf[8], rq[8]; u32x4 rv[2];
    const int vr = lt >> 4, vc16 = lt & 15;
#define HG_ROW(ch, i) (row0 + (d ? 255 - (32 * (ch) + (i)) : 32 * (ch) + (i)))
#define HG_LOAD(ch) do { _Pragma("unroll") for (int ii = 0; ii < 8; ++ii) { const bf16_t* pr = P + (size_t)HG_ROW(ch, 8 * part + ii) * 1024; rf[ii] = *(const unsigned*)(pr + fcol + c0); if (OUT) rq[ii] = *(const unsigned*)(pr + PG(PC_QB) + 128 * hb + c0); } \
        _Pragma("unroll") for (int v2 = 0; v2 < 2; ++v2) rv[v2] = *(const u32x4*)(P + PG(PC_IB) + (size_t)HG_ROW(ch, vr + 16 * v2) * 1024 + 128 * hb + 8 * vc16); } while (0)
    HG_LOAD(0);
    for (int ch = 0; ch < 8; ++ch) {
        float kk0[8], kk1[8], cs0[8], cs1[8]; float run0 = 0.f, run1 = 0.f;
#pragma unroll
        for (int ii = 0; ii < 8; ++ii) {
            { const float e = __expf(-bflo(rf[ii])), f = lb0 + om0 * __builtin_amdgcn_rcpf(1.0f + e); run0 += __builtin_amdgcn_logf(f); cs0[ii] = run0; kk0[ii] = 1.0f - f; }
            { const float e = __expf(-bfhi(rf[ii])), f = lb1 + om1 * __builtin_amdgcn_rcpf(1.0f + e); run1 += __builtin_amdgcn_logf(f); cs1[ii] = run1; kk1[ii] = 1.0f - f; } }
        *(LAS f32x2v*)(PT + part * 128 + c0) = mkf2(run0, run1);
        __syncthreads();
        const f32x2v t0 = *(LAS f32x2v*)(PT + c0), t1 = *(LAS f32x2v*)(PT + 128 + c0), t2 = *(LAS f32x2v*)(PT + 256 + c0), t3 = *(LAS f32x2v*)(PT + 384 + c0);
        const float pre0 = part == 0 ? 0.f : part == 1 ? t0.x : part == 2 ? t0.x + t1.x : t0.x + t1.x + t2.x;
        const float pre1 = part == 0 ? 0.f : part == 1 ? t0.y : part == 2 ? t0.y + t1.y : t0.y + t1.y + t2.y;
        const float gm0 = t0.x + t1.x, gm1 = t0.y + t1.y, gL0 = gm0 + t2.x + t3.x, gL1 = gm1 + t2.y + t3.y;
#pragma unroll
        for (int ii = 0; ii < 8; ++ii) { const int i = 8 * part + ii;
            if (!OUT) {
                *(LAS unsigned*)(L + HG_KT + i * HST + 2 * c0) = pk2(kk0[ii] * __builtin_amdgcn_exp2f(gL0 - pre0 - cs0[ii]), kk1[ii] * __builtin_amdgcn_exp2f(gL1 - pre1 - cs1[ii])); }
            float a0 = 0.f, a1 = 0.f;
            if (OUT) { a0 = __builtin_amdgcn_exp2f(__builtin_amdgcn_fmed3f(pre0 + cs0[ii] - gm0, -86.5f, 86.5f)); a1 = __builtin_amdgcn_exp2f(__builtin_amdgcn_fmed3f(pre1 + cs1[ii] - gm1, -86.5f, 86.5f)); }
            if (OUT) { *(LAS unsigned*)(L + HG_QT + i * HST + 2 * c0) = pk2(bflo(rq[ii]) * a0, bfhi(rq[ii]) * a1);
                *(LAS unsigned*)(L + HG_KT + i * HST + 2 * c0) = pk2(kk0[ii] * __builtin_amdgcn_rcpf(a0), kk1[ii] * __builtin_amdgcn_rcpf(a1)); } }
        if (part == 0) { *(LAS f32x2v*)(DEC + c0) = mkf2(__builtin_amdgcn_exp2f(gL0), __builtin_amdgcn_exp2f(gL1)); *(LAS f32x2v*)(EM + c0) = mkf2(__builtin_amdgcn_exp2f(gm0), __builtin_amdgcn_exp2f(gm1));
            *(LAS f32x2v*)(EL + c0) = mkf2(__builtin_amdgcn_exp2f(gL0 - gm0), __builtin_amdgcn_exp2f(gL1 - gm1)); gsum0 += gL0; gsum1 += gL1; }
#pragma unroll
        for (int v2 = 0; v2 < 2; ++v2) *(LAS u32x4*)(L + HG_VV + (vr + 16 * v2) * HST + 16 * vc16) = rv[v2];
        __syncthreads();
        if (ch < 7) HG_LOAD(ch + 1);
        bf16x8 P0, P1;
        if (OUT) {
            f32x4 s00 = (f32x4){0.f, 0.f, 0.f, 0.f}, s01 = s00, s11 = s00;
#pragma unroll
            for (int ks = 0; ks < 4; ++ks) {
                const bf16x8 K0 = *(LAS bf16x8*)(L + HG_KT + l15 * HST + (32 * ks + 8 * g) * 2), K1 = *(LAS bf16x8*)(L + HG_KT + (16 + l15) * HST + (32 * ks + 8 * g) * 2);
                const bf16x8 Q0 = *(LAS bf16x8*)(L + HG_QT + l15 * HST + (32 * ks + 8 * g) * 2), Q1 = *(LAS bf16x8*)(L + HG_QT + (16 + l15) * HST + (32 * ks + 8 * g) * 2);
                s00 = MFMA16(K0, Q0, s00); s01 = MFMA16(K0, Q1, s01); s11 = MFMA16(K1, Q1, s11); }
#pragma unroll
            for (int jj = 0; jj < 4; ++jj) { const bool ok = (4 * g + jj) <= l15; if (!ok) { s00[jj] = 0.f; s11[jj] = 0.f; } }
            P0 = pack8(s00, (f32x4){0.f, 0.f, 0.f, 0.f}); P1 = pack8(s01, s11);
        }
#pragma unroll
        for (int es = 0; es < 2; ++es) {
            const int ecol = 16 * (2 * wl + es);
            if (OUT) {
                lds_t* va = L + HG_VV + (4 * g + q4) * HST + (ecol + 4 * p4) * 2;
                const bf16x8 Vf = mk8(trrd(va), trrd(va + 16 * HST));
                f32x4 o0 = MFMA16(Vf, P0, ((f32x4){0.f, 0.f, 0.f, 0.f})), o1 = MFMA16(Vf, P1, ((f32x4){0.f, 0.f, 0.f, 0.f}));
#pragma unroll
                for (int ks = 0; ks < 4; ++ks) { const f32x4 em0 = *(LAS f32x4*)(EM + 32 * ks + 4 * g), em1 = *(LAS f32x4*)(EM + 32 * ks + 16 + 4 * g);
                    const bf16x8 Sf = pack8(Sacc[es][2 * ks] * em0, Sacc[es][2 * ks + 1] * em1);
                    lds_t* qa = L + HG_QT + l15 * HST + (32 * ks + 4 * g) * 2;
                    const bf16x8 B0 = mk8(*(LAS s16x4*)qa, *(LAS s16x4*)(qa + 32)), B1 = mk8(*(LAS s16x4*)(qa + 16 * HST), *(LAS s16x4*)(qa + 16 * HST + 32));
                    o0 = MFMA16(Sf, B0, o0); o1 = MFMA16(Sf, B1, o1); }
                { u32x2 w; w.x = pk2(o0[0], o0[1]); w.y = pk2(o0[2], o0[3]); *(u32x2*)(P + (size_t)HG_ROW(ch, l15) * 1024 + ocol + ecol + 4 * g) = w;
                  w.x = pk2(o1[0], o1[1]); w.y = pk2(o1[2], o1[3]); *(u32x2*)(P + (size_t)HG_ROW(ch, 16 + l15) * 1024 + ocol + ecol + 4 * g) = w; }
            }
            if (!OUT || ch < 7) {
                lds_t* vb = L + HG_VV + (8 * g + q4) * HST + (ecol + 4 * p4) * 2;
                const bf16x8 Vb = mk8(trrd(vb), trrd(vb + 4 * HST));
                lds_t* kb = L + HG_KT + (8 * g + q4) * HST + (4 * p4) * 2;
#pragma unroll
                for (int ct = 0; ct < 8; ++ct) { const f32x4 dc = *(LAS f32x4*)(DEC + 16 * ct + 4 * g), el = *(LAS f32x4*)(EL + 16 * ct + 4 * g);
                    const bf16x8 Ka = mk8(trrd(kb + 32 * ct), trrd(kb + 32 * ct + 4 * HST));
                    if (OUT) { const f32x4 up = MFMA16(Ka, Vb, ((f32x4){0.f, 0.f, 0.f, 0.f})); Sacc[es][ct] = Sacc[es][ct] * dc + up * el; }
                    else Sacc[es][ct] = MFMA16(Ka, Vb, Sacc[es][ct] * dc); }
            }
        }
        __syncthreads();
    }
    if (!OUT) {
#pragma unroll
        for (int es = 0; es < 2; ++es) { bf16_t* so = STB + (size_t)(scan * NSC + o) * 16384 + (size_t)(16 * (2 * wl + es) + l15) * 128 + 4 * g;
#pragma unroll
            for (int ct = 0; ct < 8; ++ct) { u32x2 w; w.x = pk2(Sacc[es][ct][0], Sacc[es][ct][1]); w.y = pk2(Sacc[es][ct][2], Sacc[es][ct][3]); *(u32x2*)(so + 16 * ct) = w; } }
        if (part == 0) *(f32x2v*)(GSUM + (size_t)(scan * NSC + o) * 128 + c0) = mkf2(gsum0, gsum1);
    }
#undef HG_ROW
#undef HG_LOAD
}

DI void hgrn_passB(bf16_t* STB, const float* GSUM) {
    const int gt = (gridDim.x - 1 - blockIdx.x) * 512 + opaque_tid(), NGT = gridDim.x * 512;
    for (int idx = gt; idx < 16 * 2048; idx += NGT) {
        const int scan = idx >> 11, off = (idx & 2047) * 8, c0 = off & 127;
        float run[8];
#pragma unroll
        for (int i = 0; i < 8; ++i) run[i] = 0.f;
        u32x4 nlv[8]; f32x4 ng0[8], ng1[8];
#define HB_LOAD(o0_) do { _Pragma("unroll") for (int k = 0; k < 8; ++k) { nlv[k] = *(const u32x4*)(STB + (size_t)(scan * NSC + (o0_) + k) * 16384 + off); \
            ng0[k] = *(const f32x4*)(GSUM + (size_t)(scan * NSC + (o0_) + k) * 128 + c0); ng1[k] = *(const f32x4*)(GSUM + (size_t)(scan * NSC + (o0_) + k) * 128 + c0 + 4); } } while (0)
        HB_LOAD(0);
        for (int o0 = 0; o0 < 64; o0 += 8) {
            u32x4 lv[8]; f32x4 g0[8], g1[8];
#pragma unroll
            for (int k = 0; k < 8; ++k) { lv[k] = nlv[k]; g0[k] = ng0[k]; g1[k] = ng1[k]; }
            if (o0 < 56) HB_LOAD(o0 + 8);
#pragma unroll
            for (int k = 0; k < 8; ++k) {
                run[0] = __builtin_amdgcn_exp2f(g0[k][0]) * run[0] + bflo(lv[k].x); run[1] = __builtin_amdgcn_exp2f(g0[k][1]) * run[1] + bfhi(lv[k].x); run[2] = __builtin_amdgcn_exp2f(g0[k][2]) * run[2] + bflo(lv[k].y); run[3] = __builtin_amdgcn_exp2f(g0[k][3]) * run[3] + bfhi(lv[k].y);
                run[4] = __builtin_amdgcn_exp2f(g1[k][0]) * run[4] + bflo(lv[k].z); run[5] = __builtin_amdgcn_exp2f(g1[k][1]) * run[5] + bfhi(lv[k].z); run[6] = __builtin_amdgcn_exp2f(g1[k][2]) * run[6] + bflo(lv[k].w); run[7] = __builtin_amdgcn_exp2f(g1[k][3]) * run[7] + bfhi(lv[k].w);
                u32x4 w; w.x = pk2(run[0], run[1]); w.y = pk2(run[2], run[3]); w.z = pk2(run[4], run[5]); w.w = pk2(run[6], run[7]);
                *(u32x4*)(STB + (size_t)(scan * NSC + o0 + k) * 16384 + off) = w; }
        }
    }
}

constexpr size_t OFF_LBS = WS_END;
constexpr size_t OFF_BAR = OFF_LBS + 4 * 1024 * 4;
constexpr size_t WS_TOTAL = OFF_BAR + 32768;


#define XB_TMO      128
#define XB_XCNT(j)  (256  + 64 * (j))
#define XB_XSUB(j)  (1280 + 64 * (j))
#define XB_XGEN(j)  (2304 + 64 * (j))
#define XB_TOP      3328
#define XB_TOPGEN   3392
#define XCD_BAR_WORDS 3456
#define XB_SPIN_CAP (1u << 22)
DI unsigned xb_ld(unsigned* p)              { return __hip_atomic_load(p, __ATOMIC_RELAXED, __HIP_MEMORY_SCOPE_AGENT); }
DI unsigned xb_add(unsigned* p, unsigned v) { return __hip_atomic_fetch_add(p, v, __ATOMIC_RELAXED, __HIP_MEMORY_SCOPE_AGENT); }
DI unsigned xb_xcc_id() { return (unsigned)__builtin_amdgcn_s_getreg((3 << 11) | 20) & 0xFu; }
#define XB_SPIN(cond, bar) do { unsigned _sp = 0; while (cond) { __builtin_amdgcn_s_sleep(1); \
    if ((++_sp & 255u) == 0u) { if (xb_ld(&(bar)[XB_TMO])) break; if (_sp > XB_SPIN_CAP) { atomicAdd(&(bar)[XB_TMO], 1u); break; } } } } while (0)
struct XcdBarrier { unsigned* bar; unsigned x; volatile LAS unsigned* st; };
DI XcdBarrier xcd_barrier_post(unsigned* bar, volatile LAS unsigned* st) {
    XcdBarrier b; b.bar = bar; b.x = xb_xcc_id(); b.st = st;
    if (threadIdx.x == 0) (void)xb_add(&bar[XB_XCNT(b.x)], 1u);
    return b;
}
DI void xcd_barrier_complete(unsigned* bar, unsigned x, unsigned& nloc, unsigned& nx) {
    const unsigned G = gridDim.x * gridDim.y * gridDim.z;
    unsigned sum, cnt, mine, sp = 0u;
    for (;;) {
        sum = 0u; cnt = 0u; mine = 0u;
#pragma unroll
        for (unsigned j = 0; j < 16; ++j) { const unsigned c = xb_ld(&bar[XB_XCNT(j)]); sum += c; cnt += (c > 0u) ? 1u : 0u; mine = (j == x) ? c : mine; }
        if (sum == G) break;
        __builtin_amdgcn_s_sleep(1);
        if ((++sp & 255u) == 0u) { if (xb_ld(&bar[XB_TMO])) break; if (sp > XB_SPIN_CAP) { atomicAdd(&bar[XB_TMO], 1u); break; } }
    }
    nloc = mine > 0u ? mine : 1u; nx = cnt > 0u ? cnt : 1u;
}
DI void xcd_barrier(const XcdBarrier& b) {
    asm volatile("s_waitcnt vmcnt(0) lgkmcnt(0)" ::: "memory");
    __syncthreads();
    if (threadIdx.x == 0) {
        unsigned* bar = b.bar;
        __builtin_amdgcn_s_waitcnt(0);
        unsigned nloc = b.st[0], nx = b.st[1];
        if (nloc == 0u) { xcd_barrier_complete(bar, b.x, nloc, nx); b.st[0] = nloc; b.st[1] = nx; }
        const unsigned old = xb_add(&bar[XB_XSUB(b.x)], 1u);
        const unsigned gen = old / nloc;
        if (old + 1u == (gen + 1u) * nloc) {
            __builtin_amdgcn_fence(__ATOMIC_RELEASE, "agent");
            asm volatile("s_waitcnt vmcnt(0)" ::: "memory");
            const unsigned og = xb_add(&bar[XB_TOP], 1u);
            const unsigned tg = og / nx;
            if (og + 1u == (tg + 1u) * nx) xb_add(&bar[XB_TOPGEN], 1u);
            else XB_SPIN(xb_ld(&bar[XB_TOPGEN]) == tg, bar);
            __builtin_amdgcn_fence(__ATOMIC_ACQUIRE, "agent");
            xb_add(&bar[XB_XGEN(b.x)], 1u);
            asm volatile("s_waitcnt vmcnt(0)" ::: "memory");
        } else {
            XB_SPIN(xb_ld(&bar[XB_XGEN(b.x)]) == gen, bar);
            __builtin_amdgcn_fence(__ATOMIC_ACQUIRE, "agent");
            asm volatile("s_waitcnt vmcnt(0)" ::: "memory");
        }
    }
    __syncthreads();
}
DI kparams_t ldp() { kparams_t k = (kparams_t)__builtin_amdgcn_kernarg_segment_ptr(); asm volatile("" : "+s"(k)); return k; }
#define WSP(type, off) ((type*)(q->ws + (off)))
#ifndef REP_H
#define REP_H 1
#endif
#ifndef REP_M
#define REP_M 1
#endif
#ifndef REP_G
#define REP_G 1
#endif
#ifndef REP_T
#define REP_T 1
#endif
#ifndef REP_B
#define REP_B 1
#endif
#ifndef REP_X
#define REP_X 1
#endif
#ifndef DUMP
#define DUMP 0
#endif

__global__ void __launch_bounds__(512, 2) fwd_megakernel(Params p_unused) {
    extern __shared__ __attribute__((aligned(16))) unsigned char lds_raw[];
    lds_t* L = (lds_t*)lds_raw;
    cg::grid_group grid = cg::this_grid();
    volatile LAS unsigned* bst = (volatile LAS unsigned*)(L + LDS_BYTES - 16);
    if (threadIdx.x < 4) bst[threadIdx.x] = 0u;
    __syncthreads();
    grid.sync();
    const XcdBarrier xbar = xcd_barrier_post((unsigned*)(ldp()->ws + OFF_BAR), bst);
#define GSYNC() for (int rb_ = 0; rb_ < REP_B; ++rb_) xcd_barrier(xbar)
    volatile LAS int* wqw = (volatile LAS int*)(L + LDS_BYTES - 32);
#define WQ_BEGIN(ctr_, n_) { unsigned* wqc_ = (ctr_); int nxt_ = 0; if (threadIdx.x == 0) nxt_ = (int)__hip_atomic_fetch_add(wqc_, 1u, __ATOMIC_RELAXED, __HIP_MEMORY_SCOPE_AGENT); \
        for (;;) { __syncthreads(); if (threadIdx.x == 0) *wqw = nxt_; __syncthreads(); const int u = __builtin_amdgcn_readfirstlane(*wqw); if (u >= (n_)) break; \
            if (threadIdx.x == 0) nxt_ = (int)__hip_atomic_fetch_add(wqc_, 1u, __ATOMIC_RELAXED, __HIP_MEMORY_SCOPE_AGENT);
#define WQ_END() } }

    { kparams_t q = ldp(); float* LBS = WSP(float, OFF_LBS);
      for (int c = blockIdx.x * 512 + threadIdx.x; c < 1024; c += gridDim.x * 512) {
        const float a0 = q->lb_logits[c], a1 = q->lb_logits[1024 + c], a2 = q->lb_logits[2048 + c], a3 = q->lb_logits[3072 + c];
        const float mx = fmaxf(fmaxf(a0, a1), fmaxf(a2, a3)); const float e0 = __expf(a0 - mx), e1 = __expf(a1 - mx), e2 = __expf(a2 - mx), e3 = __expf(a3 - mx); const float inv = 1.0f / (e0 + e1 + e2 + e3);
        LBS[c] = 0.f; LBS[1024 + c] = e1 * inv; LBS[2048 + c] = (e1 + e2) * inv; LBS[3072 + c] = (e1 + e2 + e3) * inv; }
      phase_ada(q, L, WSP(float, OFF_MOD)); }
    GSYNC();

    for (int l = 0; l < DEPTH; ++l) {
        for (int b = 0; b < NB; ++b) {
            { kparams_t q = ldp();
              for (int rep = 0; rep < REP_T; ++rep) if (b == 0) phase_wconv(q, L, l, WSP(bf16_t, OFF_BTIN), WSP(bf16_t, OFF_BTA), WSP(bf16_t, OFF_BTB), WSP(bf16_t, OFF_BTO), WSP(float, OFF_BIAS));
              const float* xl_src = (l == 0 ? q->x : q->out) + (size_t)b * SEQ * DM; const float* xc_src = (l == 0 ? q->ctx : WSP(float, OFF_XC)) + (size_t)b * CTX * DM;
              for (int rep = 0; rep < REP_X; ++rep) phase_norm(q, l, b, xl_src, xc_src, WSP(float, OFF_MOD), WSP(bf16_t, OFF_HA)); }
            GSYNC();
            { kparams_t q = ldp(); pg8::Gemm g{WSP(bf16_t, OFF_HA), WSP(bf16_t, OFF_BTIN), MB, NPAD, DM, DM}; pg8::StaticOrder S; S.init(MB, NPAD, gridDim.x, blockIdx.x);
              EpiIn E{WSP(bf16_t, OFF_P), WSP(float, OFF_G), WSP(float, OFF_BIAS)};
              for (int rep = 0; rep < REP_G; ++rep) pg8::gemm_phase<EpiIn, pg8::StaticOrder>(L, g, S, E); }
            GSYNC();
            { kparams_t q = ldp(); for (int rep = 0; rep < REP_T; ++rep) phase_conv(q, l, WSP(bf16_t, OFF_P), WSP(bf16_t, OFF_QKC)); }
            GSYNC();
            { kparams_t q = ldp();
              unsigned* wqc4 = (unsigned*)(q->ws + OFF_BAR) + 4096 + 64 * (4 * l + 2 * b);
              int nx4 = 0; if (threadIdx.x == 0) nx4 = (int)__hip_atomic_fetch_add(wqc4, 1u, __ATOMIC_RELAXED, __HIP_MEMORY_SCOPE_AGENT);
#define WQ4_DRAW(u_) do { __syncthreads(); if (threadIdx.x == 0) *wqw = nx4; __syncthreads(); (u_) = __builtin_amdgcn_readfirstlane(*wqw); \
        if (threadIdx.x == 0 && (u_) < 16 * NSC) nx4 = (int)__hip_atomic_fetch_add(wqc4, 1u, __ATOMIC_RELAXED, __HIP_MEMORY_SCOPE_AGENT); } while (0)
              int u4; WQ4_DRAW(u4);
              while (u4 < 8 * NSC) { hgrn_item<false>(u4, L, WSP(bf16_t, OFF_P), WSP(bf16_t, OFF_STB), WSP(float, OFF_GSUM), WSP(float, OFF_LBS) + l * 1024); WQ4_DRAW(u4); }
              while (u4 < 16 * NSC) { mlstm_passA(u4 - 8 * NSC, L, WSP(bf16_t, OFF_P), WSP(bf16_t, OFF_QKC), WSP(float, OFF_G), WSP(bf16_t, OFF_STA), WSP(float, OFF_NST), WSP(float, OFF_SCA)); WQ4_DRAW(u4); }
#undef WQ4_DRAW
            }
            GSYNC();
            { kparams_t q = ldp(); mlstm_passB(WSP(bf16_t, OFF_STA), WSP(float, OFF_NST), WSP(float, OFF_SCA)); }
            { kparams_t q = ldp(); hgrn_passB(WSP(bf16_t, OFF_STB), WSP(float, OFF_GSUM)); }
            GSYNC();
            { kparams_t q = ldp();
              unsigned* wqc6 = (unsigned*)(q->ws + OFF_BAR) + 4096 + 64 * (4 * l + 2 * b + 1);
              int nx6 = 0; if (threadIdx.x == 0) nx6 = (int)__hip_atomic_fetch_add(wqc6, 1u, __ATOMIC_RELAXED, __HIP_MEMORY_SCOPE_AGENT);
#define WQ6_DRAW(u_) do { __syncthreads(); if (threadIdx.x == 0) *wqw = nx6; __syncthreads(); (u_) = __builtin_amdgcn_readfirstlane(*wqw); \
        if (threadIdx.x == 0 && (u_) < 24 * NSC) nx6 = (int)__hip_atomic_fetch_add(wqc6, 1u, __ATOMIC_RELAXED, __HIP_MEMORY_SCOPE_AGENT); } while (0)
              int u6; WQ6_DRAW(u6);
              while (u6 < 8 * NSC) { hgrn_item<true>(u6, L, WSP(bf16_t, OFF_P), WSP(bf16_t, OFF_STB), WSP(float, OFF_GSUM), WSP(float, OFF_LBS) + l * 1024); WQ6_DRAW(u6); }
              while (u6 < 24 * NSC) {
                  const int v = u6 - 8 * NSC, it2 = v < 8 * NSC ? v : v - 8 * NSC, dd = (it2 / NSC) & 1, qb = (v < 8 * NSC) ? 1 - dd : dd;
                  mlstm_passC(2 * it2 + qb, L, WSP(bf16_t, OFF_P), WSP(bf16_t, OFF_HA), WSP(bf16_t, OFF_HB2), WSP(bf16_t, OFF_QKC), WSP(float, OFF_G), WSP(bf16_t, OFF_STA), WSP(float, OFF_NST), WSP(float, OFF_SCA));
                  WQ6_DRAW(u6); }
#undef WQ6_DRAW
            }
            GSYNC();
            { kparams_t q = ldp(); phase_post(q, l, WSP(bf16_t, OFF_P), WSP(bf16_t, OFF_HA), WSP(bf16_t, OFF_HB2)); }
            GSYNC();
            { kparams_t q = ldp(); pg8::Gemm g{WSP(bf16_t, OFF_P) + PG(PC_O) + (size_t)CTX * DM, WSP(bf16_t, OFF_BTA), SEQ, DM, DM, DM}; PairOrder S; S.init(gridDim.x, blockIdx.x); EpiMergeF E{WSP(bf16_t, OFF_P), WSP(bf16_t, OFF_HA)};
              pg8::gemm_phase<EpiMergeF, PairOrder>(L, g, S, E); }
            if (l < DEPTH - 1) { kparams_t q = ldp(); const bf16_t* Pp = WSP(bf16_t, OFF_P);
              ctx_patch<0>(L, Pp + PG(PC_O), WSP(bf16_t, OFF_BTA), Pp + PG(PC_ZB), WSP(bf16_t, OFF_BTB), Pp + PG(PC_MA), Pp + PG(PC_MB), WSP(bf16_t, OFF_HA), nullptr, nullptr, nullptr); }
            GSYNC();
            { kparams_t q = ldp(); pg8::Gemm g{WSP(bf16_t, OFF_HA) + (size_t)CTX * DM, WSP(bf16_t, OFF_BTO), SEQ, DM, DM, DM}; pg8::StaticOrder S; S.init(SEQ, DM, gridDim.x, blockIdx.x);
              const float* xl_src = (l == 0 ? q->x : q->out) + (size_t)b * SEQ * DM; float* xl_dst = q->out + (size_t)b * SEQ * DM;
              EpiOut E{xl_src, xl_dst, WSP(float, OFF_MOD) + (l * 3 + b) * 3072 + 2048};
              pg8::gemm_phase<EpiOut, pg8::StaticOrder>(L, g, S, E); }
            if (l < DEPTH - 1) { kparams_t q = ldp();
              const float* xc_src = (l == 0 ? q->ctx : WSP(float, OFF_XC)) + (size_t)b * CTX * DM; float* xc_dst = WSP(float, OFF_XC) + (size_t)b * CTX * DM;
              ctx_patch<1>(L, WSP(bf16_t, OFF_HA), WSP(bf16_t, OFF_BTO), nullptr, nullptr, nullptr, nullptr, nullptr, xc_src, xc_dst, WSP(float, OFF_MOD) + (l * 3 + 2) * 3072 + 2048); }
            GSYNC();
        }
    }
    { kparams_t q = ldp(); phase_final(q, q->out); }
}

extern "C" void kernel_launch(void* const* d_in, const int* in_sizes, int n_in, void* d_out, int out_size, void* d_ws, size_t ws_size, hipStream_t stream) {
    static int grid = 0;
    if (grid == 0) {
        int dev = 0, cus = 0, per_cu = 0;
        if (n_in != 18 || ws_size < WS_TOTAL) { fprintf(stderr, "kernel_launch: unexpected n_in %d / ws_size %zu (need %zu)\n", n_in, ws_size, (size_t)WS_TOTAL); }
        hipGetDevice(&dev); hipDeviceGetAttribute(&cus, hipDeviceAttributeMultiprocessorCount, dev);
        hipFuncSetAttribute((const void*)fwd_megakernel, hipFuncAttributeMaxDynamicSharedMemorySize, LDS_BYTES);
        hipOccupancyMaxActiveBlocksPerMultiprocessor(&per_cu, (const void*)fwd_megakernel, 512, LDS_BYTES);
        if (per_cu < 1) { fprintf(stderr, "kernel_launch: occupancy query gave %d\n", per_cu); per_cu = 1; }
        (void)hipGetLastError();
        grid = cus * per_cu;
    }
    if (ws_size < WS_TOTAL) return;
    Params p; memset(&p, 0, sizeof(p));
    const float** pf = (const float**)&p;
    for (int i = 0; i < 18; ++i) pf[i] = (const float*)d_in[i];
    p.out = (float*)d_out; p.ws = (unsigned char*)d_ws;
    (void)hipMemsetAsync((unsigned char*)d_ws + OFF_BAR, 0, 32768, stream);
    void* args[] = {&p};
    hipError_t e = hipLaunchCooperativeKernel((const void*)fwd_megakernel, dim3(grid), dim3(512), args, LDS_BYTES, stream);
    if (e != hipSuccess) fprintf(stderr, "cooperative launch failed: %s (grid %d)\n", hipGetErrorString(e), grid);
}
```
